# Optimizing an MI355X kernel written in HIP

```python
import numpy as np
import jax
import jax.numpy as jnp
from jax import lax

D_MODEL = 1024
BATCH = 32
SEQ = 256
DEPTH = 2
DEC_BATCH = 2
DEC_SEQ = 2048
PAST_LEN = 512

GRID_W = 64
HEAD_DIM = 64
MIX_WIDTH = D_MODEL
A_HEADS = 4
A_DK = 64
A_DV = 64
A_WIDTH = A_HEADS * A_DV
B_WIDTH = D_MODEL // 4
CONV_K = 31
CONV_PAD = (CONV_K - 1) // 2
C_HEADS = 8
C_KV_HEADS = 2
C_WIDTH = C_HEADS * HEAD_DIM
D_FF = 2816
HGRN_CHUNK = 16
Q_BLOCK = 128
ROPE_THETA = 10000.0
ROPE_PAIRS = HEAD_DIM // 4
N_MOD = 9
ALPHA = (2 * DEPTH) ** 0.25
BETA = (8 * DEPTH) ** -0.25
F_MIN = 1e-6
IN_SIZES = (A_WIDTH, A_WIDTH, A_WIDTH, A_WIDTH, A_WIDTH, 2 * B_WIDTH, C_WIDTH,
            C_KV_HEADS * HEAD_DIM, C_KV_HEADS * HEAD_DIM)
IN_WIDTH = 5 * A_WIDTH + 2 * B_WIDTH + C_WIDTH + 2 * C_KV_HEADS * HEAD_DIM

kernel_name = "hybrid_hgrn2_conformer_gqa_diffusion_step"


def _layer_norm(x, g, b, eps=1e-5):
    xf = x.astype(jnp.float32)
    mu = jnp.mean(xf, axis=-1, keepdims=True)
    var = jnp.mean(jnp.square(xf - mu), axis=-1, keepdims=True)
    return ((xf - mu) * lax.rsqrt(var + eps) * g + b).astype(x.dtype)


def _rms_norm(x, g, eps=1e-6):
    xf = x.astype(jnp.float32)
    return (xf * lax.rsqrt(jnp.mean(jnp.square(xf), axis=-1, keepdims=True) + eps) * g).astype(x.dtype)


def _modulate(x, shift, scale):
    return x * (1.0 + scale) + shift


def _swiglu(h, w_in, w_out):
    gate, up = jnp.split(h @ w_in, 2, axis=-1)
    return (jax.nn.silu(gate) * up) @ w_out


def _axial_rope_tables(seq):
    rows = seq // GRID_W
    row_id = jnp.repeat(jnp.arange(rows), GRID_W).astype(jnp.float32)
    col_id = jnp.tile(jnp.arange(GRID_W), rows).astype(jnp.float32)
    inv = ROPE_THETA ** (-jnp.arange(ROPE_PAIRS, dtype=jnp.float32) / ROPE_PAIRS)
    ang = jnp.stack([row_id[:, None] * inv, col_id[:, None] * inv], axis=0)
    return jnp.cos(ang), jnp.sin(ang)


def _apply_rope(x, cos, sin):
    halves = jnp.split(x.astype(jnp.float32), 2, axis=-1)
    out = []
    for axis in range(2):
        x1, x2 = jnp.split(halves[axis], 2, axis=-1)
        cs = cos[axis][None, :, None, :]
        sn = sin[axis][None, :, None, :]
        out += [x1 * cs - x2 * sn, x2 * cs + x1 * sn]
    return jnp.concatenate(out, axis=-1).astype(x.dtype)


def _block_attention(q, k, v):
    bsz, seq_q, heads, hd = q.shape
    kvh = k.shape[2]
    groups = heads // kvh
    nblk = seq_q // Q_BLOCK
    qb = jnp.moveaxis(q.reshape(bsz, nblk, Q_BLOCK, kvh, groups, hd), 1, 0)
    scale = hd ** -0.5

    def one_block(q_blk):
        s = jnp.einsum("bqkgd,bskd->bkgqs", q_blk, k).astype(jnp.float32) * scale
        p = jax.nn.softmax(s, axis=-1).astype(v.dtype)
        return jnp.einsum("bkgqs,bskd->bqkgd", p, v)

    o = lax.map(one_block, qb)
    return jnp.moveaxis(o, 0, 1).reshape(bsz, seq_q, heads * hd)


def _hgrn_scan(q, k, v, logf, s0):
    bsz, seq, heads, _ = q.shape
    dv = v.shape[-1]
    n = seq // HGRN_CHUNK
    chunk = lambda t: t.astype(jnp.float32).reshape(bsz, n, HGRN_CHUNK, heads, t.shape[-1])
    q, k, v, logf = chunk(q), chunk(k), chunk(v), chunk(logf)
    a = jnp.cumsum(logf, axis=2)
    a_last = a[:, :, -1]
    tri = jnp.tril(jnp.ones((HGRN_CHUNK, HGRN_CHUNK), dtype=bool))[None, None, :, :, None, None]
    diff = a[:, :, :, None] - a[:, :, None, :]
    decay = jnp.where(tri, jnp.exp(jnp.where(tri, diff, 0.0)), 0.0)
    scores = jnp.einsum("bntshd,bnshd->bnhts", q[:, :, :, None] * decay, k)
    o_intra = jnp.einsum("bnhts,bnshe->bnthe", scores, v)
    kv = jnp.einsum("bnshd,bnshe->bnhde", k * jnp.exp(a_last[:, :, None] - a), v)

    def step(state, inp):
        dec, kv_n = inp
        return dec[..., None] * state + kv_n, state

    s_fin, s_prev = lax.scan(step, s0.astype(jnp.float32),
                             (jnp.moveaxis(jnp.exp(a_last), 1, 0), jnp.moveaxis(kv, 1, 0)))
    s_prev = jnp.moveaxis(s_prev, 0, 1)
    o_inter = jnp.einsum("bnthd,bnhde->bnthe", q * jnp.exp(a), s_prev)
    return (o_intra + o_inter).reshape(bsz, seq, heads, dv), s_fin


def _depthwise_conv(u, w, b):
    out = lax.conv_general_dilated(
        u, w[:, None, :].astype(u.dtype), window_strides=(1,),
        padding=[(CONV_PAD, CONV_PAD)], dimension_numbers=("NWC", "WIO", "NWC"),
        feature_group_count=u.shape[-1])
    return out + b


def _mixer(h, p, lb, ctx):
    bsz, seq, _ = h.shape
    z = h @ p["w_in"]
    cuts = [int(i) for i in np.cumsum(IN_SIZES)[:-1]]
    zq, zi, zff, zfb, zg, zglu, cq, ck, cv = jnp.split(z, cuts, axis=-1)

    heads_a = lambda t: t.reshape(bsz, seq, A_HEADS, -1)
    lb_h = lb.reshape(A_HEADS, A_DK)

    def forget(zf):
        f = lb_h + (1.0 - lb_h) * jax.nn.sigmoid(heads_a(zf).astype(jnp.float32))
        return 1.0 - f, jnp.log(jnp.maximum(f, F_MIN))

    qa, ia = heads_a(zq), heads_a(zi)
    k_fw, logf_fw = forget(zff)
    k_bw, logf_bw = forget(zfb)
    s0 = jnp.zeros((bsz, 2, A_HEADS, A_DK, A_DV), jnp.float32) if ctx is None else ctx[2]
    rev = lambda t: t[:, ::-1]
    o_fw, s_fw = _hgrn_scan(qa, k_fw, ia, logf_fw, s0[:, 0])
    o_bw, s_bw = _hgrn_scan(rev(qa), rev(k_bw), rev(ia), rev(logf_bw), s0[:, 1])
    o_a = _rms_norm(o_fw + rev(o_bw), p["hgrn_norm_g"].reshape(A_HEADS, A_DV))
    o_a = (o_a * jax.nn.silu(heads_a(zg).astype(jnp.float32))).astype(h.dtype).reshape(bsz, seq, A_WIDTH)

    glu_a, glu_b = jnp.split(zglu, 2, axis=-1)
    u = _depthwise_conv(glu_a * jax.nn.sigmoid(glu_b), p["conv_w"], p["conv_b"])
    o_conv = jax.nn.silu(_layer_norm(u, p["conv_ln_g"], p["conv_ln_b"]))

    qc = _rms_norm(cq.reshape(bsz, seq, C_HEADS, HEAD_DIM), p["q_norm_g"])
    kc = _rms_norm(ck.reshape(bsz, seq, C_KV_HEADS, HEAD_DIM), p["k_norm_g"])
    vc = cv.reshape(bsz, seq, C_KV_HEADS, HEAD_DIM)
    if ctx is None:
        o_c = _block_attention(qc, kc, vc)
        new = (kc, vc, jnp.stack([s_fw, s_bw], axis=1))
    else:
        cos, sin = _axial_rope_tables(seq)
        k_all = jnp.concatenate([ctx[0].astype(kc.dtype), _apply_rope(kc, cos, sin)], axis=1)
        v_all = jnp.concatenate([ctx[1].astype(vc.dtype), vc], axis=1)
        o_c = _block_attention(_apply_rope(qc, cos, sin), k_all, v_all)
        new = None

    y = jnp.concatenate([o_a, o_conv, o_c], axis=-1) @ p["w_out"]
    return y, new


def _layer(x, cond, p, lb, ctx):
    mod = (jax.nn.silu(cond) @ p["w_mod"] + p["b_mod"])[:, None, :]
    sh1, sc1, g1, sh2, sc2, g2, sh3, sc3, g3 = jnp.split(mod, N_MOD, axis=-1)
    f1 = _swiglu(_modulate(x, sh1, sc1), p["ffn1_w_in"], p["ffn1_w_out"])
    x = _layer_norm(ALPHA * x + 0.5 * g1 * f1, p["ln_g"][0], p["ln_b"][0])
    y, new = _mixer(_modulate(x, sh2, sc2), p, lb, ctx)
    x = _layer_norm(ALPHA * x + g2 * y, p["ln_g"][1], p["ln_b"][1])
    f2 = _swiglu(_modulate(x, sh3, sc3), p["ffn2_w_in"], p["ffn2_w_out"])
    x = _layer_norm(ALPHA * x + 0.5 * g3 * f2, p["ln_g"][2], p["ln_b"][2])
    return x, new


def setup_inputs(seed: int = 0) -> dict:
    key = jax.random.key(seed)
    ks = jax.random.split(key, 26)

    def nrm(i, shape, scale):
        return jax.random.normal(ks[i], shape, jnp.float32) * scale

    return {
        "x_prompt": nrm(0, (BATCH, SEQ, D_MODEL), 1.0),
        "x_sample": nrm(1, (DEC_BATCH, DEC_SEQ, D_MODEL), 1.0),
        "cache_k": nrm(2, (DEC_BATCH, DEPTH, PAST_LEN, C_KV_HEADS, HEAD_DIM), 1.0),
        "cache_v": nrm(3, (DEC_BATCH, DEPTH, PAST_LEN, C_KV_HEADS, HEAD_DIM), 1.0),
        "state_hgrn": nrm(4, (DEC_BATCH, DEPTH, 2, A_HEADS, A_DK, A_DV), 0.5),
        "c": nrm(5, (DEC_BATCH, D_MODEL), 1.0),
        "c_ctx": nrm(6, (D_MODEL,), 1.0),
        "w_mod": nrm(7, (DEPTH, D_MODEL, N_MOD * D_MODEL), 0.5 * D_MODEL ** -0.5),
        "b_mod": nrm(8, (DEPTH, N_MOD * D_MODEL), 0.02),
        "ln_g": jnp.ones((DEPTH, 3, D_MODEL), jnp.float32) + nrm(9, (DEPTH, 3, D_MODEL), 0.02),
        "ln_b": nrm(10, (DEPTH, 3, D_MODEL), 0.02),
        "ffn1_w_in": nrm(11, (DEPTH, D_MODEL, 2 * D_FF), D_MODEL ** -0.5),
        "ffn1_w_out": nrm(12, (DEPTH, D_FF, D_MODEL), BETA * D_FF ** -0.5),
        "ffn2_w_in": nrm(13, (DEPTH, D_MODEL, 2 * D_FF), D_MODEL ** -0.5),
        "ffn2_w_out": nrm(14, (DEPTH, D_FF, D_MODEL), BETA * D_FF ** -0.5),
        "w_in": nrm(15, (DEPTH, D_MODEL, IN_WIDTH), D_MODEL ** -0.5),
        "w_out": nrm(16, (DEPTH, MIX_WIDTH, D_MODEL), BETA * MIX_WIDTH ** -0.5),
        "hgrn_lb_logits": nrm(17, (DEPTH, A_HEADS * A_DK), 1.0),
        "hgrn_norm_g": jnp.ones((DEPTH, A_WIDTH), jnp.float32) + nrm(18, (DEPTH, A_WIDTH), 0.02),
        "conv_w": nrm(19, (DEPTH, CONV_K, B_WIDTH), CONV_K ** -0.5),
        "conv_b": nrm(20, (DEPTH, B_WIDTH), 0.02),
        "conv_ln_g": jnp.ones((DEPTH, B_WIDTH), jnp.float32) + nrm(21, (DEPTH, B_WIDTH), 0.02),
        "conv_ln_b": nrm(22, (DEPTH, B_WIDTH), 0.02),
        "q_norm_g": jnp.ones((DEPTH, HEAD_DIM), jnp.float32) + nrm(23, (DEPTH, HEAD_DIM), 0.02),
        "k_norm_g": jnp.ones((DEPTH, HEAD_DIM), jnp.float32) + nrm(24, (DEPTH, HEAD_DIM), 0.02),
    }


def reference(x_prompt, x_sample, cache_k, cache_v, state_hgrn, c, c_ctx, w_mod, b_mod, ln_g, ln_b,
              ffn1_w_in, ffn1_w_out, ffn2_w_in, ffn2_w_out, w_in, w_out, hgrn_lb_logits,
              hgrn_norm_g, conv_w, conv_b, conv_ln_g, conv_ln_b, q_norm_g, k_norm_g):
    lb_soft = jax.nn.softmax(hgrn_lb_logits.astype(jnp.float32), axis=0)
    lbs = jnp.cumsum(lb_soft, axis=0) - lb_soft[0:1]
    xp, xs = x_prompt, x_sample
    ks, vs, ss = [], [], []
    for l in range(DEPTH):
        p = {
            "w_mod": w_mod[l], "b_mod": b_mod[l], "ln_g": ln_g[l], "ln_b": ln_b[l],
            "ffn1_w_in": ffn1_w_in[l], "ffn1_w_out": ffn1_w_out[l],
            "ffn2_w_in": ffn2_w_in[l], "ffn2_w_out": ffn2_w_out[l],
            "w_in": w_in[l], "w_out": w_out[l], "hgrn_norm_g": hgrn_norm_g[l],
            "conv_w": conv_w[l], "conv_b": conv_b[l], "conv_ln_g": conv_ln_g[l],
            "conv_ln_b": conv_ln_b[l], "q_norm_g": q_norm_g[l], "k_norm_g": k_norm_g[l],
        }
        xp, (k_l, v_l, s_l) = _layer(xp, c_ctx[None, :], p, lbs[l], None)
        ks.append(k_l)
        vs.append(v_l)
        ss.append(s_l)
        xs, _ = _layer(xs, c, p, lbs[l], (cache_k[:, l], cache_v[:, l], state_hgrn[:, l]))
    new_cache_k = jnp.stack(ks, axis=1)
    new_cache_v = jnp.stack(vs, axis=1)
    new_state_hgrn = jnp.stack(ss, axis=1)
    return (xp, xs, new_cache_k, new_cache_v, new_state_hgrn)
```

```cpp
#include <hip/hip_runtime.h>
#include <hip/hip_cooperative_groups.h>
#include <cstdio>
#include <cstdint>
namespace cg = cooperative_groups;
namespace pg8 {
#define PG8_LAS __attribute__((address_space(3)))
typedef unsigned short bf16_t;
typedef short bf16x8 __attribute__((ext_vector_type(8)));
typedef float f32x4 __attribute__((ext_vector_type(4)));
typedef unsigned u32x4 __attribute__((ext_vector_type(4)));
constexpr int BM = 256, BK = 64, HALF = 128, HTB = HALF * BK * 2  , STAGE_BYTES = 8 * HTB, NXCD = 8, WGM = 8;

__host__ __device__ __forceinline__ int lds_byte(int r, int c) { const int st = (r >> 4) * 2 + (c >> 5), rr = r & 15, cc = c & 31, ob = rr * 64 + cc * 2; return st * 1024 + (ob ^ (((ob >> 9) & 1) << 5)); }
__host__ __device__ __forceinline__ void stage_rc(int b, int& R, int& C) { const int st = b / 1024, sb = b % 1024, swz = sb ^ (((sb >> 9) & 1) << 5); R = (st >> 1) * 16 + swz / 64; C = (st & 1) * 32 + (swz % 64) / 2; }
__host__ __device__ __forceinline__ int perm32(int rho) { const int n = rho >> 4, i = rho & 15; return 8 * (i >> 2) + 4 * n + (i & 3); }

struct Unit { int pm, pn; };
struct Gemm { const bf16_t* A; const bf16_t* Bt; int M, N, K; };

struct StaticOrder {
    int nM, nN, nwg, G, c;
    __host__ __device__ void init(int M, int N, int G_, int c_) { nM = M / BM; nN = N / BM; nwg = nM * nN; G = G_; c = c_; }
    __host__ __device__ bool next(int i, Unit& u) const {
        const long L = (long)i * G + c; if (L >= nwg) return false;
        int wgid = (int)L; { const int q = nwg / NXCD, r = nwg % NXCD, xcd = wgid % NXCD, off = wgid / NXCD; wgid = (xcd < r ? xcd * (q + 1) : r * (q + 1) + (xcd - r) * q) + off; }
        const int nig = WGM * nN, gid = wgid / nig, fm = gid * WGM, gsz = (nM - fm) < WGM ? (nM - fm) : WGM;
        u.pm = fm + ((wgid % nig) % gsz); u.pn = (wgid % nig) / gsz; return true;
    }
    __device__ __forceinline__ void a_ready(const Unit&) const {}
    __device__ __forceinline__ void done(const Unit&) const {}
};
__device__ __forceinline__ unsigned cvt_pk_bf16(float lo, float hi) { unsigned r; asm volatile("v_cvt_pk_bf16_f32 %0, %1, %2" : "=v"(r) : "v"(lo), "v"(hi)); return r; }
template <class Epi, class Sched, bool ALIGN_EPI = false, bool SP2 = false>
__device__ __forceinline__ void gemm_phase(PG8_LAS unsigned char* lds, const Gemm g, const Sched& S, const Epi& E) {
    int tid_o = threadIdx.x; asm volatile("" : "+v"(tid_o)); const int tid = tid_o, wid = __builtin_amdgcn_readfirstlane(tid >> 6), lane = tid & 63, wr = wid >> 2, wc = wid & 3, fr = lane & 15, fq = lane >> 4;
    const int K = g.K, nt = K / BK;
    unsigned voffA[2], voffB[2];
#pragma unroll
    for (int i = 0; i < 2; ++i) { int R, C; stage_rc(tid * 16 + i * 8192, R, C); const int Rb = Epi::PERM ? ((R & ~31) + perm32(R & 31)) : R;
        voffA[i] = (unsigned)(R * K + C) * 2u; voffB[i] = (unsigned)(Rb * K + C) * 2u; }
    const size_t kstep = (size_t)(BK * 2);
    const size_t hstep = (size_t)HALF * K * 2;
    const size_t tstep = 2 * hstep;
    const unsigned ldsw = (unsigned)wid * 1024u;
    const int aoff = lds_byte(wr * 64 + fr, fq * 8), boff = lds_byte(wc * 32 + fr, fq * 8);
#define PG8_SA(b, h) (((b) * 2 + (h)) * HTB)
#define PG8_SB(b, h) ((4 + (b) * 2 + (h)) * HTB)
#define PG8_STAGE(bufoff, gbase, voff) do { _Pragma("unroll") for (int _i = 0; _i < 2; ++_i) \
        __builtin_amdgcn_global_load_lds((const unsigned*)((const char*)(gbase) + (voff)[_i]), (PG8_LAS unsigned*)(lds + (bufoff) + ldsw + _i * 8192), 16, 0, 0); } while (0)
#define PG8_LDA(dst, b, h) do { _Pragma("unroll") for (int m = 0; m < 4; ++m) _Pragma("unroll") for (int k = 0; k < 2; ++k) dst[m][k] = *(const PG8_LAS bf16x8*)(lds + PG8_SA(b, h) + aoff + m * 2048 + k * 1024); } while (0)
#define PG8_LDB(dst, b, h) do { _Pragma("unroll") for (int n = 0; n < 2; ++n) _Pragma("unroll") for (int k = 0; k < 2; ++k) dst[n][k] = *(const PG8_LAS bf16x8*)(lds + PG8_SB(b, h) + boff + n * 2048 + k * 1024); } while (0)
#define PG8_MMA(ai, bj, At, Bt) do { __builtin_amdgcn_s_setprio(1); _Pragma("unroll") for (int m = 0; m < 4; ++m) _Pragma("unroll") for (int n = 0; n < 2; ++n) _Pragma("unroll") for (int k = 0; k < 2; ++k) \
        acc[ai][bj][m][n] = __builtin_amdgcn_mfma_f32_16x16x32_bf16(Bt[n][k], At[m][k], acc[ai][bj][m][n], 0, 0, 0); __builtin_amdgcn_s_setprio(0); } while (0)
#define PG8_WAIT_V(n) asm volatile("s_waitcnt vmcnt(" #n ")" ::: "memory")
#define PG8_WAIT_L(n) asm volatile("s_waitcnt lgkmcnt(" #n ")" ::: "memory")
#define PG8_BAR __builtin_amdgcn_s_barrier()
#define PG8_SCHED __builtin_amdgcn_sched_barrier(0)
    Unit cur, nxt; int ui = 0;
    if (!S.next(0, cur)) return;
    f32x4 acc[2][2][4][2];
#pragma unroll
    for (int a = 0; a < 2; ++a)
#pragma unroll
        for (int b = 0; b < 2; ++b)
#pragma unroll
            for (int m = 0; m < 4; ++m)
#pragma unroll
                for (int n = 0; n < 2; ++n) acc[a][b][m][n] = (f32x4){0.f, 0.f, 0.f, 0.f};
    bf16x8 At[4][2], B0[2][2], B1[2][2];
    const char* cA = (const char*)g.A + (size_t)cur.pm * tstep; const char* cB = (const char*)g.Bt + (size_t)cur.pn * tstep;
    S.a_ready(cur);
    if constexpr (SP2) {
        PG8_STAGE(PG8_SB(0, 0), cB, voffB); PG8_STAGE(PG8_SB(0, 1), cB + hstep, voffB); PG8_STAGE(PG8_SA(0, 0), cA, voffA); PG8_STAGE(PG8_SA(0, 1), cA + hstep, voffA);
        if (wr == 1) PG8_BAR;
        PG8_WAIT_V(2); PG8_BAR;
        PG8_STAGE(PG8_SB(1, 0), cB + kstep, voffB); PG8_STAGE(PG8_SA(1, 0), cA + kstep, voffA); PG8_STAGE(PG8_SB(1, 1), cB + hstep + kstep, voffB);
        PG8_WAIT_V(6); PG8_BAR;
    } else {
        PG8_STAGE(PG8_SB(0, 0), cB, voffB); PG8_STAGE(PG8_SA(0, 0), cA, voffA); PG8_STAGE(PG8_SB(0, 1), cB + hstep, voffB); PG8_STAGE(PG8_SA(0, 1), cA + hstep, voffA);
        if (wr == 1) PG8_BAR;
        PG8_WAIT_V(4); PG8_BAR;
        PG8_STAGE(PG8_SB(1, 0), cB + kstep, voffB); PG8_STAGE(PG8_SA(1, 0), cA + kstep, voffA); PG8_STAGE(PG8_SB(1, 1), cB + hstep + kstep, voffB);
        PG8_WAIT_V(6); PG8_BAR;
    }
    for (;;) {
        const bool has_next = S.next(ui + 1, nxt);
        const char* nA = has_next ? (const char*)g.A + (size_t)nxt.pm * tstep : cA; const char* nB = has_next ? (const char*)g.Bt + (size_t)nxt.pn * tstep : cB;
        for (int t = 0; t < nt; t += 2) {
            const bool last = (t == nt - 2);
            const char* a1 = cA + (size_t)(t + 1) * kstep;
            const char* a2 = last ? nA : cA + (size_t)(t + 2) * kstep; const char* b2 = last ? nB : cB + (size_t)(t + 2) * kstep;
            const char* a3 = a2 + kstep; const char* b3 = b2 + kstep;
            if (last && has_next) S.a_ready(nxt);
            if constexpr (SP2) {
            PG8_LDB(B0, 0, 0); PG8_LDB(B1, 0, 1); PG8_SCHED; PG8_LDA(At, 0, 0); PG8_STAGE(PG8_SA(1, 1), a1 + hstep, voffA);
            PG8_WAIT_V(8); PG8_WAIT_L(0); PG8_BAR; PG8_MMA(0, 0, At, B0); PG8_MMA(0, 1, At, B1); PG8_BAR; PG8_SCHED;
            PG8_LDA(At, 0, 1); PG8_STAGE(PG8_SB(0, 0), b2, voffB); PG8_STAGE(PG8_SB(0, 1), b2 + hstep, voffB); PG8_STAGE(PG8_SA(0, 0), a2, voffA);
            PG8_WAIT_V(8); PG8_WAIT_L(0); PG8_BAR; PG8_MMA(1, 0, At, B0); PG8_MMA(1, 1, At, B1); PG8_BAR; PG8_SCHED;
            PG8_LDB(B0, 1, 0); PG8_LDB(B1, 1, 1); PG8_SCHED; PG8_LDA(At, 1, 0); PG8_STAGE(PG8_SA(0, 1), a2 + hstep, voffA);
            PG8_WAIT_V(8); PG8_WAIT_L(0); PG8_BAR; PG8_MMA(0, 0, At, B0); PG8_MMA(0, 1, At, B1); PG8_BAR; PG8_SCHED;
            PG8_LDA(At, 1, 1); PG8_STAGE(PG8_SB(1, 0), b3, voffB); PG8_STAGE(PG8_SB(1, 1), b3 + hstep, voffB); PG8_STAGE(PG8_SA(1, 0), a3, voffA);
            PG8_WAIT_V(8); PG8_WAIT_L(0); PG8_BAR; PG8_MMA(1, 0, At, B0); PG8_MMA(1, 1, At, B1); PG8_BAR; PG8_SCHED;
            } else {
            PG8_LDB(B0, 0, 0); PG8_SCHED; PG8_LDA(At, 0, 0); PG8_STAGE(PG8_SA(1, 1), a1 + hstep, voffA);
            PG8_WAIT_L(8); PG8_BAR; PG8_WAIT_L(0); PG8_MMA(0, 0, At, B0); PG8_BAR; PG8_SCHED;
            PG8_LDB(B1, 0, 1); PG8_STAGE(PG8_SB(0, 0), b2, voffB);
            PG8_BAR; PG8_WAIT_L(0); PG8_MMA(0, 1, At, B1); PG8_BAR;
            PG8_LDA(At, 0, 1); PG8_STAGE(PG8_SA(0, 0), a2, voffA);
            PG8_BAR; PG8_WAIT_L(0); PG8_MMA(1, 0, At, B0); PG8_BAR; PG8_SCHED;
            PG8_STAGE(PG8_SB(0, 1), b2 + hstep, voffB);
            PG8_WAIT_V(6); PG8_BAR; PG8_MMA(1, 1, At, B1); PG8_BAR;
            PG8_LDB(B0, 1, 0); PG8_SCHED; PG8_LDA(At, 1, 0); PG8_STAGE(PG8_SA(0, 1), a2 + hstep, voffA);
            PG8_WAIT_L(8); PG8_BAR; PG8_WAIT_L(0); PG8_MMA(0, 0, At, B0); PG8_BAR; PG8_SCHED;
            PG8_LDB(B1, 1, 1); PG8_STAGE(PG8_SB(1, 0), b3, voffB);
            PG8_BAR; PG8_WAIT_L(0); PG8_MMA(0, 1, At, B1); PG8_BAR;
            PG8_LDA(At, 1, 1); PG8_STAGE(PG8_SA(1, 0), a3, voffA);
            PG8_BAR; PG8_WAIT_L(0); PG8_MMA(1, 0, At, B0); PG8_BAR; PG8_SCHED;
            PG8_STAGE(PG8_SB(1, 1), b3 + hstep, voffB);
            PG8_WAIT_V(6); PG8_BAR; PG8_MMA(1, 1, At, B1); PG8_BAR;
            }
        }
        if constexpr (ALIGN_EPI) { if (wr == 0) PG8_BAR; }
        if constexpr (!Epi::AFTER_DRAIN) { E(acc, cur, wr, wc, fr, fq); S.done(cur); }
        if (!has_next) break;
#pragma unroll
        for (int a = 0; a < 2; ++a)
#pragma unroll
            for (int b = 0; b < 2; ++b)
#pragma unroll
                for (int m = 0; m < 4; ++m)
#pragma unroll
                    for (int n = 0; n < 2; ++n) acc[a][b][m][n] = (f32x4){0.f, 0.f, 0.f, 0.f};
        cur = nxt; cA = nA; cB = nB; ++ui;
        if constexpr (ALIGN_EPI) { if (wr == 1) PG8_BAR; }
    }
    PG8_WAIT_V(0);
    if constexpr (!ALIGN_EPI) { if (wr == 0) PG8_BAR; }
    PG8_BAR;
    if constexpr (Epi::AFTER_DRAIN) { E.fused(acc, cur, wr, wc, fr, fq, lds, wid, lane); S.done(cur); }
#undef PG8_SA
#undef PG8_SB
#undef PG8_STAGE
#undef PG8_LDA
#undef PG8_LDB
#undef PG8_MMA
#undef PG8_WAIT_V
#undef PG8_WAIT_L
#undef PG8_BAR
#undef PG8_SCHED
}
}

#define LAS __attribute__((address_space(3)))
typedef unsigned short bf16_t;
typedef short bf16x8 __attribute__((ext_vector_type(8)));
typedef float f32x4 __attribute__((ext_vector_type(4)));
typedef float f32x2 __attribute__((ext_vector_type(2)));
typedef unsigned u32x4 __attribute__((ext_vector_type(4)));
typedef unsigned u32x2 __attribute__((ext_vector_type(2)));

constexpr int D = 1024, DFF = 2816, NIN = 2560, T = 12288, TCTX = 8192;
constexpr int NMOD = 9216;
constexpr float ALPHA = 1.41421356237309515f;
constexpr float QSCALE = 0.125f * 1.44269504088896341f;
constexpr int NTHREADS = 512, NWAVES = 8;
constexpr int LDS_BYTES = 147456;
#ifndef EN_MASK
#define EN_MASK 0xFFFF
#endif

constexpr size_t MiB = 1u << 20;
constexpr size_t WS_CTL = 0, CTL_BYTES = 4096;
constexpr size_t WS_MOD = 65536;
constexpr size_t WS_ROPE = 524288;
constexpr size_t WS_W = 2 * MiB, W_LAYER = 40 * MiB;
constexpr size_t W_1IN = 0, W_1OUT = 11 * MiB, W_2IN = 16 * MiB + MiB / 2, W_2OUT = 27 * MiB + MiB / 2, W_IN = 33 * MiB, W_OUT = 38 * MiB;
constexpr size_t WS_X = 82 * MiB;
constexpr size_t WS_A = 130 * MiB;
constexpr size_t WS_HZ = 154 * MiB;
constexpr size_t WS_Q = 220 * MiB;
constexpr size_t WS_K = 232 * MiB, WS_V = 236 * MiB;
constexpr size_t WS_OH = 240 * MiB;
constexpr size_t WS_END = 264 * MiB;
constexpr int KV_LAT_OFF = 32 * 2 * 256 * 64;
constexpr size_t OUT_Y = 0, OUT_CK = (size_t)T * D, OUT_CV = OUT_CK + 2097152, OUT_ST = OUT_CV + 2097152;

struct Params { const float* in[25]; float* out; unsigned char* ws; };

__device__ __forceinline__ unsigned cvt_pk(float lo, float hi) { unsigned r; asm("v_cvt_pk_bf16_f32 %0, %1, %2" : "=v"(r) : "v"(lo), "v"(hi)); return r; }
typedef __bf16 bf16x2_t __attribute__((ext_vector_type(2)));
__device__ __forceinline__ unsigned cvt_pk_c(float lo, float hi) { unsigned r; asm volatile("v_cvt_pk_bf16_f32 %0, %1, %2\n\ts_nop 1" : "=v"(r) : "v"(lo), "v"(hi)); return r; }
__device__ __forceinline__ float bf_lo(unsigned u) { return __uint_as_float(u << 16); }
__device__ __forceinline__ float bf_hi(unsigned u) { return __uint_as_float(u & 0xffff0000u); }
__device__ __forceinline__ float silu_f(float x) { return x / (1.0f + __expf(-x)); }
__device__ __forceinline__ float sigmoid_f(float x) { return 1.0f / (1.0f + __expf(-x)); }
__device__ __forceinline__ float wave_sum(float v) {
#pragma unroll
    for (int o = 1; o < 64; o <<= 1) v += __shfl_xor(v, o);
    return v;
}
__device__ __forceinline__ int otid() { int t = threadIdx.x; asm volatile("" : "+v"(t)); return t; }
__device__ __forceinline__ int cond_of_row(int row) { return row < TCTX ? 0 : 1 + ((row - TCTX) >> 11); }

struct EpiSwiglu {
    static constexpr bool PERM = true, AFTER_DRAIN = false;
    bf16_t* H;
    __device__ __forceinline__ void operator()(const pg8::f32x4 (&acc)[2][2][4][2], const pg8::Unit& u, int wr, int wc, int fr, int fq) const {
        const int row0 = u.pm * 256 + wr * 64 + fr, col0 = u.pn * 128 + wc * 32 + 8 * fq;
#pragma unroll
        for (int ai = 0; ai < 2; ++ai)
#pragma unroll
            for (int m = 0; m < 4; ++m) {
                bf16_t* rowp = H + (size_t)(row0 + ai * 128 + m * 16) * DFF + col0;
                float h[8];
#pragma unroll
                for (int n = 0; n < 2; ++n)
#pragma unroll
                    for (int i = 0; i < 4; ++i) { const float g = acc[ai][0][m][n][i], up = acc[ai][1][m][n][i]; h[n * 4 + i] = silu_f(g) * up; }
                u32x4 w; w.x = cvt_pk(h[0], h[1]); w.y = cvt_pk(h[2], h[3]); w.z = cvt_pk(h[4], h[5]); w.w = cvt_pk(h[6], h[7]);
                *(u32x4*)rowp = w;
            }
    }
};
struct EpiZ {
    static constexpr bool PERM = true, AFTER_DRAIN = false;
    bf16_t* O; int ldc;
    __device__ __forceinline__ void operator()(const pg8::f32x4 (&acc)[2][2][4][2], const pg8::Unit& u, int wr, int wc, int fr, int fq) const {
        const int row0 = u.pm * 256 + wr * 64 + fr, col0 = u.pn * 256 + wc * 32 + 8 * fq;
#pragma unroll
        for (int ai = 0; ai < 2; ++ai)
#pragma unroll
            for (int m = 0; m < 4; ++m) {
                bf16_t* rowp = O + (size_t)(row0 + ai * 128 + m * 16) * ldc + col0;
#pragma unroll
                for (int bj = 0; bj < 2; ++bj) {
                    const pg8::f32x4 v0 = acc[ai][bj][m][0], v1 = acc[ai][bj][m][1];
                    u32x4 w; w.x = cvt_pk(v0[0], v0[1]); w.y = cvt_pk(v0[2], v0[3]); w.z = cvt_pk(v1[0], v1[1]); w.w = cvt_pk(v1[2], v1[3]);
                    *(u32x4*)(rowp + bj * 128) = w;
                }
            }
    }
};
struct EpiResid {
    static constexpr bool PERM = false, AFTER_DRAIN = false;
    float* X; const float* gate; float s;
    __device__ __forceinline__ void operator()(const pg8::f32x4 (&acc)[2][2][4][2], const pg8::Unit& u, int wr, int wc, int fr, int fq) const {
        const int cond = u.pm < 32 ? 0 : 1 + ((u.pm - 32) >> 3);
        const float* gv = gate + cond * NMOD;
        const int row0 = u.pm * 256 + wr * 64 + fr, col0 = u.pn * 256 + wc * 32 + 4 * fq;
#pragma unroll
        for (int bj = 0; bj < 2; ++bj)
#pragma unroll
            for (int n = 0; n < 2; ++n) {
                const int c = col0 + bj * 128 + n * 16;
                const f32x4 g = *(const f32x4*)(gv + c) * s;
#pragma unroll
                for (int ai = 0; ai < 2; ++ai)
#pragma unroll
                    for (int m = 0; m < 4; ++m) {
                        f32x4* px = (f32x4*)(X + (size_t)(row0 + ai * 128 + m * 16) * D + c);
                        const f32x4 xv = *px;
                        *px = xv * ALPHA + g * acc[ai][bj][m][n];
                    }
            }
    }
};

__device__ __forceinline__ void transpose_item(const float* W, int K, int N, bf16_t* WT, int k0, int n0, int dst_row0, LAS float* scr, int lane) {
#pragma unroll 8
    for (int i = 0; i < 32; ++i) { const int kk = 2 * i + (lane >> 5); scr[kk * 33 + (lane & 31)] = W[(size_t)(k0 + kk) * N + n0 + (lane & 31)]; }
    asm volatile("s_waitcnt lgkmcnt(0)" ::: "memory");
    const int c = lane & 7;
#pragma unroll
    for (int j = 0; j < 4; ++j) {
        const int n = (lane >> 3) + 8 * j; const LAS float* s = scr + (8 * c) * 33 + n;
        u32x4 o; o.x = cvt_pk(s[0 * 33], s[1 * 33]); o.y = cvt_pk(s[2 * 33], s[3 * 33]); o.z = cvt_pk(s[4 * 33], s[5 * 33]); o.w = cvt_pk(s[6 * 33], s[7 * 33]);
        *(u32x4*)(WT + (size_t)(dst_row0 + n) * K + k0 + 8 * c) = o;
    }
    asm volatile("s_waitcnt lgkmcnt(0)" ::: "memory");
}
__device__ __forceinline__ int swiglu_row(int n) { return n < DFF ? (n >> 7) * 256 + (n & 127) : ((n - DFF) >> 7) * 256 + 128 + ((n - DFF) & 127); }

__device__ __forceinline__ void mod_item(const Params& p, int it, LAS unsigned char* lds) {
    const int tid = otid();
    LAS float* sl = (LAS float*)lds;
    LAS float* red = sl + 3072;
    const int l = it / 72, cg0 = (it % 72) * 128;
    for (int i = tid; i < 3072; i += NTHREADS) { const int c = i >> 10, k = i & 1023; const float v = c == 0 ? p.in[6][k] : p.in[5][(c - 1) * 1024 + k]; sl[i] = silu_f(v); }
    __syncthreads();
    const int cq = tid & 31, ks = tid >> 5;
    const float* w = p.in[7] + ((size_t)l * 1024 + ks * 64) * NMOD + cg0 + cq * 4;
    f32x4 a0 = {0.f, 0.f, 0.f, 0.f}, a1 = a0, a2 = a0;
#pragma unroll 8
    for (int k = 0; k < 64; ++k) {
        const f32x4 wv = *(const f32x4*)(w + (size_t)k * NMOD); const int kk = ks * 64 + k;
        a0 += wv * sl[kk]; a1 += wv * sl[1024 + kk]; a2 += wv * sl[2048 + kk];
    }
    *(LAS f32x4*)(red + (ks * 3 + 0) * 128 + cq * 4) = a0;
    *(LAS f32x4*)(red + (ks * 3 + 1) * 128 + cq * 4) = a1;
    *(LAS f32x4*)(red + (ks * 3 + 2) * 128 + cq * 4) = a2;
    __syncthreads();
    if (tid < 384) {
        const int c = tid >> 7, col = tid & 127; float s = 0.f;
#pragma unroll
        for (int k = 0; k < 16; ++k) s += red[(k * 3 + c) * 128 + col];
        ((float*)(p.ws + WS_MOD))[(size_t)(l * 3 + c) * NMOD + cg0 + col] = s + p.in[8][(size_t)l * NMOD + cg0 + col];
    }
    __syncthreads();
}

__device__ __forceinline__ void prologue(const Params& p, LAS unsigned char* lds) {
    const int tid = otid(), lane = tid & 63, wave = tid >> 6;
    const int G = gridDim.x;
    for (int it = blockIdx.x; it < 144; it += G) mod_item(p, it, lds);
    if (blockIdx.x == G - 1) {
        float* rc = (float*)(p.ws + WS_ROPE);
        for (int i = tid; i < 1024; i += NTHREADS) {
            const int pos = i >> 4, pp = i & 15;
            const float inv = exp2f(-(float)pp * (13.287712379549449f / 16.0f));
            const float ang = (float)pos * inv;
            rc[i] = cosf(ang); rc[1024 + i] = sinf(ang);
        }
    }
    __syncthreads();
    LAS float* scr = (LAS float*)(lds + wave * 16384);
    const int gw = blockIdx.x * NWAVES + wave, NGW = G * NWAVES;
    for (int it = gw; it < 20480; it += NGW) {
        const int l = it / 10240; int r = it % 10240;
        bf16_t* wl = (bf16_t*)(p.ws + WS_W + (size_t)l * W_LAYER);
        if (r < 5632) {
            const int which = r / 2816; r %= 2816;
            const int kb = r / 176, nb = r % 176;
            const float* W = p.in[which ? 13 : 11] + (size_t)l * 1024 * 5632;
            transpose_item(W, 1024, 5632, (bf16_t*)((unsigned char*)wl + (which ? W_2IN : W_1IN)), kb * 64, nb * 32, swiglu_row(nb * 32), scr, lane);
        } else if (r < 5632 + 2816) {
            r -= 5632; const int which = r / 1408; r %= 1408;
            const int kb = r / 32, nb = r % 32;
            const float* W = p.in[which ? 14 : 12] + (size_t)l * 2816 * 1024;
            transpose_item(W, 2816, 1024, (bf16_t*)((unsigned char*)wl + (which ? W_2OUT : W_1OUT)), kb * 64, nb * 32, nb * 32, scr, lane);
        } else if (r < 5632 + 2816 + 1280) {
            r -= 5632 + 2816; const int kb = r / 80, nb = r % 80;
            transpose_item(p.in[15] + (size_t)l * 1024 * 2560, 1024, 2560, (bf16_t*)((unsigned char*)wl + W_IN), kb * 64, nb * 32, nb * 32, scr, lane);
        } else {
            r -= 5632 + 2816 + 1280; const int kb = r / 32, nb = r % 32;
            transpose_item(p.in[16] + (size_t)l * 1024 * 1024, 1024, 1024, (bf16_t*)((unsigned char*)wl + W_OUT), kb * 64, nb * 32, nb * 32, scr, lane);
        }
    }
}

__device__ __forceinline__ void store_mod_row(bf16_t* arow, const f32x4 (&x)[4], const float* sh, const float* sc, int lane) {
#pragma unroll
    for (int j = 0; j < 4; ++j) {
        const int c = 4 * lane + 256 * j;
        const f32x4 s = *(const f32x4*)(sh + c), k = *(const f32x4*)(sc + c);
        const f32x4 a = x[j] * (k + 1.0f) + s;
        u32x2 w; w.x = cvt_pk(a[0], a[1]); w.y = cvt_pk(a[2], a[3]);
        *(u32x2*)(arow + c) = w;
    }
}
__device__ __forceinline__ void init_rows(const Params& p) {
    const int tid_ = otid(); const int lane = tid_ & 63, wave = tid_ >> 6;
    const int gw = blockIdx.x * NWAVES + wave, NGW = gridDim.x * NWAVES;
    float* X = (float*)(p.ws + WS_X); bf16_t* A = (bf16_t*)(p.ws + WS_A); const float* MOD = (const float*)(p.ws + WS_MOD);
    for (int row = gw; row < T; row += NGW) {
        const float* src = row < TCTX ? p.in[0] + (size_t)row * D : p.in[1] + (size_t)(row - TCTX) * D;
        const int cond = cond_of_row(row);
        f32x4 v[4];
#pragma unroll
        for (int j = 0; j < 4; ++j) { v[j] = *(const f32x4*)(src + 4 * lane + 256 * j); *(f32x4*)(X + (size_t)row * D + 4 * lane + 256 * j) = v[j]; }
        store_mod_row(A + (size_t)row * D, v, MOD + cond * NMOD + 0 * 1024, MOD + cond * NMOD + 1 * 1024, lane);
    }
}
__device__ __forceinline__ void ln_rows(const Params& p, const float* g, const float* b, const float* modn, int shi, float* final_out) {
    const int tid_ = otid(); const int lane = tid_ & 63, wave = tid_ >> 6;
    const int gw = blockIdx.x * NWAVES + wave, NGW = gridDim.x * NWAVES;
    float* X = (float*)(p.ws + WS_X); bf16_t* A = (bf16_t*)(p.ws + WS_A);
    for (int row = gw; row < T; row += NGW) {
        f32x4 v[4]; float s = 0.f;
#pragma unroll
        for (int j = 0; j < 4; ++j) { v[j] = *(const f32x4*)(X + (size_t)row * D + 4 * lane + 256 * j); s += (v[j][0] + v[j][1]) + (v[j][2] + v[j][3]); }
        const float mean = wave_sum(s) * (1.0f / D); float q = 0.f;
#pragma unroll
        for (int j = 0; j < 4; ++j) { v[j] = v[j] - mean; q += (v[j][0] * v[j][0] + v[j][1] * v[j][1]) + (v[j][2] * v[j][2] + v[j][3] * v[j][3]); }
        const float rstd = 1.0f / sqrtf(wave_sum(q) * (1.0f / D) + 1e-5f);
        float* dst = final_out ? final_out + (size_t)row * D : X + (size_t)row * D;
#pragma unroll
        for (int j = 0; j < 4; ++j) {
            const int c = 4 * lane + 256 * j;
            v[j] = v[j] * rstd * *(const f32x4*)(g + c) + *(const f32x4*)(b + c);
            *(f32x4*)(dst + c) = v[j];
        }
        if (!final_out) { const int cond = cond_of_row(row); store_mod_row(A + (size_t)row * D, v, modn + cond * NMOD + shi * 1024, modn + cond * NMOD + (shi + 1) * 1024, lane); }
    }
}

#ifndef STATIC_Q
#define STATIC_Q 1
#endif
__device__ __forceinline__ int next_item(unsigned* ctr, LAS int* slot, int& k) {
    __syncthreads();
#if STATIC_Q
    const int r = blockIdx.x + k * gridDim.x; ++k; return r;
#else
    if (threadIdx.x == 0) *slot = (int)atomicAdd(ctr, 1u);
    __syncthreads();
    return *slot;
#endif
}

__device__ __forceinline__ void prep_item(const Params& p, int l, int it) {
    const int tid_ = otid(); const int lane = tid_ & 63, wave = tid_ >> 6;
    const bf16_t* Z = (const bf16_t*)(p.ws + WS_HZ);
    bf16_t* Qb = (bf16_t*)(p.ws + WS_Q); bf16_t* Kb = (bf16_t*)(p.ws + WS_K); bf16_t* Vb = (bf16_t*)(p.ws + WS_V);
    const float* rc = (const float*)(p.ws + WS_ROPE);
    const int sb = lane & 7;
    float gq[8], gk[8];
#pragma unroll
    for (int i = 0; i < 8; ++i) { gq[i] = p.in[23][l * 64 + sb * 8 + i]; gk[i] = p.in[24][l * 64 + sb * 8 + i]; }
    for (int r8 = 0; r8 < 8; ++r8) {
        const int row = it * 64 + wave * 8 + r8;
        const bool lat = row >= TCTX;
        const int tl = lat ? ((row - TCTX) & 2047) : (row & 255);
        const int pos = (sb < 4) ? (tl >> 6) : (tl & 63);
        float cs[8], sn[8];
#pragma unroll
        for (int i = 0; i < 8; ++i) { cs[i] = rc[pos * 16 + (sb & 1) * 8 + i]; sn[i] = rc[1024 + pos * 16 + (sb & 1) * 8 + i]; }
        {
            const u32x4 z = *(const u32x4*)(Z + (size_t)row * NIN + 1792 + lane * 8);
            float x[8] = {bf_lo(z.x), bf_hi(z.x), bf_lo(z.y), bf_hi(z.y), bf_lo(z.z), bf_hi(z.z), bf_lo(z.w), bf_hi(z.w)};
            float ss = 0.f;
#pragma unroll
            for (int i = 0; i < 8; ++i) ss += x[i] * x[i];
            ss += __shfl_xor(ss, 1); ss += __shfl_xor(ss, 2); ss += __shfl_xor(ss, 4);
            const float rr = 1.0f / sqrtf(ss * (1.0f / 64.0f) + 1e-6f);
#pragma unroll
            for (int i = 0; i < 8; ++i) x[i] = x[i] * rr * gq[i];
#pragma unroll
            for (int i = 0; i < 8; ++i) {
                const float o = __shfl_xor(x[i], 2);
                const float r = (sb & 2) ? x[i] * cs[i] + o * sn[i] : x[i] * cs[i] - o * sn[i];
                x[i] = (lat ? r : x[i]) * QSCALE;
            }
            u32x4 w; w.x = cvt_pk(x[0], x[1]); w.y = cvt_pk(x[2], x[3]); w.z = cvt_pk(x[4], x[5]); w.w = cvt_pk(x[6], x[7]);
            *(u32x4*)(Qb + (size_t)row * 512 + lane * 8) = w;
        }
        {
            const int ln = lane & 31;
            const u32x4 z = *(const u32x4*)(Z + (size_t)row * NIN + 2304 + ln * 8);
            float x[8] = {bf_lo(z.x), bf_hi(z.x), bf_lo(z.y), bf_hi(z.y), bf_lo(z.z), bf_hi(z.z), bf_lo(z.w), bf_hi(z.w)};
            float ss = 0.f;
#pragma unroll
            for (int i = 0; i < 8; ++i) ss += x[i] * x[i];
            ss += __shfl_xor(ss, 1); ss += __shfl_xor(ss, 2); ss += __shfl_xor(ss, 4);
            const float rr = 1.0f / sqrtf(ss * (1.0f / 64.0f) + 1e-6f);
            const bool isk = ln < 16;
#pragma unroll
            for (int i = 0; i < 8; ++i) {
                const float xn = x[i] * rr * gk[i];
                const float o = __shfl_xor(xn, 2);
                const float r = (sb & 2) ? xn * cs[i] + o * sn[i] : xn * cs[i] - o * sn[i];
                x[i] = isk ? (lat ? r : xn) : x[i];
            }
            if (lane < 32) {
                const int kvh = (ln >> 3) & 1;
                bf16_t* dstb = isk ? Kb : Vb;
                size_t off;
                if (!lat) { const int s = row >> 8; off = ((size_t)(s * 2 + kvh) * 256 + tl) * 64 + sb * 8; }
                else { const int bb = (row - TCTX) >> 11; off = (size_t)KV_LAT_OFF + ((size_t)(bb * 2 + kvh) * 2560 + 512 + tl) * 64 + sb * 8; }
                u32x4 w; w.x = cvt_pk(x[0], x[1]); w.y = cvt_pk(x[2], x[3]); w.z = cvt_pk(x[4], x[5]); w.w = cvt_pk(x[6], x[7]);
                *(u32x4*)(dstb + off) = w;
                if (!lat) {
                    const int s = row >> 8;
                    float* o = p.out + (isk ? OUT_CK : OUT_CV) + ((((size_t)s * 2 + l) * 256 + tl) * 2 + kvh) * 64 + sb * 8;
                    *(f32x4*)o = (f32x4){x[0], x[1], x[2], x[3]}; *(f32x4*)(o + 4) = (f32x4){x[4], x[5], x[6], x[7]};
                }
            }
        }
    }
}
__device__ __forceinline__ void prepc_item(const Params& p, int l, int it) {
    const int tid_ = otid(); const int lane = tid_ & 63, wave = tid_ >> 6;
    bf16_t* Kb = (bf16_t*)(p.ws + WS_K); bf16_t* Vb = (bf16_t*)(p.ws + WS_V);
    for (int r = 0; r < 16; ++r) {
        const int bp = it * 128 + wave * 16 + r;
        const int bb = bp >> 9, pos = bp & 511;
        if (lane < 32) {
            const bool isk = lane < 16; const int ln = lane & 15, kvh = ln >> 3, sb = ln & 7;
            const float* src = (isk ? p.in[2] : p.in[3]) + ((((size_t)bb * 2 + l) * 512 + pos) * 2 + kvh) * 64 + sb * 8;
            const f32x4 a = *(const f32x4*)src, b = *(const f32x4*)(src + 4);
            u32x4 w; w.x = cvt_pk(a[0], a[1]); w.y = cvt_pk(a[2], a[3]); w.z = cvt_pk(b[0], b[1]); w.w = cvt_pk(b[2], b[3]);
            *(u32x4*)((isk ? Kb : Vb) + (size_t)KV_LAT_OFF + ((size_t)(bb * 2 + kvh) * 2560 + pos) * 64 + sb * 8) = w;
        }
    }
}

__device__ __forceinline__ void hgrn_item(const Params& p, int l, int L, int rowbase, int bidx, bool lat, int h, int dir, int eg, LAS unsigned char* lds) {
    const int tid = otid();
    LAS float* qs = (LAS float*)lds;
    LAS float* fs = qs + 4096;
    LAS float* ks = fs + 4096;
    LAS float* vs = ks + 4096;
    LAS float* part = vs + 1024;
    const bf16_t* Z = (const bf16_t*)(p.ws + WS_HZ);
    float* OH = (float*)(p.ws + WS_OH) + (size_t)dir * T * 256;
    const int ss = tid >> 4, sj = tid & 15;
    float lbv[4];
#pragma unroll
    for (int i = 0; i < 4; ++i) {
        const int dd = h * 64 + 4 * sj + i;
        lbv[i] = (l == 0) ? 0.f : 1.0f / (1.0f + __expf(p.in[17][dd] - p.in[17][256 + dd]));
    }
    const int cq = h * 64 + 4 * sj, cf = (dir ? 768 : 512) + h * 64 + 4 * sj, cv = 256 + h * 64 + eg * 16 + sj;
    const int el = tid & 15, dg = tid >> 4;
    float S0 = 0.f, S1 = 0.f;
    if (lat) {
        const float* s0 = p.in[4] + ((((size_t)bidx * 2 + l) * 2 + dir) * 4 + h) * 4096;
        S0 = s0[(2 * dg) * 64 + eg * 16 + el]; S1 = s0[(2 * dg + 1) * 64 + eg * 16 + el];
    }
    const int nb = L >> 5;
    u32x2 rq, rf; unsigned short rv;
#define HG_LOAD(bt) do { const int n_ = (bt) * 32 + ss; const int t_ = dir ? (L - 1 - n_) : n_; const bf16_t* zr_ = Z + (size_t)(rowbase + t_) * NIN; \
        rq = *(const u32x2*)(zr_ + cq); rf = *(const u32x2*)(zr_ + cf); rv = zr_[cv]; } while (0)
#define HG_STAGE(buf) do { const float zq_[4] = {bf_lo(rq.x), bf_hi(rq.x), bf_lo(rq.y), bf_hi(rq.y)}; const float zf_[4] = {bf_lo(rf.x), bf_hi(rf.x), bf_lo(rf.y), bf_hi(rf.y)}; \
        f32x4 fq_, ff_, fk_; _Pragma("unroll") for (int i = 0; i < 4; ++i) { const float f_ = lbv[i] + (1.0f - lbv[i]) * sigmoid_f(zf_[i]); fq_[i] = zq_[i]; ff_[i] = fmaxf(f_, 1e-6f); fk_[i] = 1.0f - f_; } \
        *(LAS f32x4*)(qs + (buf) * 2048 + ss * 64 + 4 * sj) = fq_; *(LAS f32x4*)(fs + (buf) * 2048 + ss * 64 + 4 * sj) = ff_; *(LAS f32x4*)(ks + (buf) * 2048 + ss * 64 + 4 * sj) = fk_; \
        vs[(buf) * 512 + ss * 16 + sj] = __uint_as_float((unsigned)rv << 16); } while (0)
    HG_LOAD(0);
    HG_STAGE(0);
    __syncthreads();
    for (int bt = 0; bt < nb; ++bt) {
        const int cur = bt & 1;
        if (bt + 1 < nb) HG_LOAD(bt + 1);
        const LAS float* q_ = qs + cur * 2048 + 2 * dg; const LAS float* f_ = fs + cur * 2048 + 2 * dg; const LAS float* k_ = ks + cur * 2048 + 2 * dg;
        const LAS float* v_ = vs + cur * 512 + el;
#pragma unroll 8
        for (int s = 0; s < 32; ++s) {
            const f32x2 f2 = *(const LAS f32x2*)(f_ + s * 64), k2 = *(const LAS f32x2*)(k_ + s * 64), q2 = *(const LAS f32x2*)(q_ + s * 64);
            const float v = v_[s * 16];
            S0 = f2[0] * S0 + k2[0] * v; S1 = f2[1] * S1 + k2[1] * v;
            part[s * 528 + tid] = q2[0] * S0 + q2[1] * S1;
        }
        __syncthreads();
        {
            float o = 0.f;
#pragma unroll
            for (int g = 0; g < 32; ++g) o += part[ss * 528 + g * 16 + sj];
            const int n = bt * 32 + ss; const int t = dir ? (L - 1 - n) : n;
            OH[(size_t)(rowbase + t) * 256 + h * 64 + eg * 16 + sj] = o;
        }
        if (bt + 1 < nb) HG_STAGE(cur ^ 1);
        __syncthreads();
    }
#undef HG_LOAD
#undef HG_STAGE
    if (!lat) {
        float* sf = p.out + OUT_ST + ((((size_t)bidx * 2 + l) * 2 + dir) * 4 + h) * 4096;
        sf[(2 * dg) * 64 + eg * 16 + el] = S0; sf[(2 * dg + 1) * 64 + eg * 16 + el] = S1;
    }
}

__device__ __forceinline__ void hfin_item(const Params& p, int l, int it) {
    const int tid_ = otid(); const int lane = tid_ & 63, wave = tid_ >> 6;
    const bf16_t* Z = (const bf16_t*)(p.ws + WS_HZ); const float* OH = (const float*)(p.ws + WS_OH); bf16_t* O = (bf16_t*)(p.ws + WS_A);
    const f32x4 g = *(const f32x4*)(p.in[18] + l * 256 + lane * 4);
    for (int r8 = 0; r8 < 8; ++r8) {
        const int row = it * 64 + wave * 8 + r8;
        const f32x4 a = *(const f32x4*)(OH + (size_t)row * 256 + lane * 4) + *(const f32x4*)(OH + (size_t)T * 256 + (size_t)row * 256 + lane * 4);
        float ss = (a[0] * a[0] + a[1] * a[1]) + (a[2] * a[2] + a[3] * a[3]);
        ss += __shfl_xor(ss, 1); ss += __shfl_xor(ss, 2); ss += __shfl_xor(ss, 4); ss += __shfl_xor(ss, 8);
        const float rr = 1.0f / sqrtf(ss * (1.0f / 64.0f) + 1e-6f);
        const u32x2 z = *(const u32x2*)(Z + (size_t)row * NIN + 1024 + lane * 4);
        const float o0 = a[0] * rr * g[0] * silu_f(bf_lo(z.x)), o1 = a[1] * rr * g[1] * silu_f(bf_hi(z.x));
        const float o2 = a[2] * rr * g[2] * silu_f(bf_lo(z.y)), o3 = a[3] * rr * g[3] * silu_f(bf_hi(z.y));
        u32x2 w; w.x = cvt_pk(o0, o1); w.y = cvt_pk(o2, o3);
        *(u32x2*)(O + (size_t)row * D + lane * 4) = w;
    }
}

__device__ __forceinline__ void conv_item(const Params& p, int l, int it, LAS unsigned char* lds) {
    const int tid = otid(), lane = tid & 63, wave = tid >> 6;
    LAS float* ul = (LAS float*)lds;
    LAS float* res = ul + 62 * 256;
    const bf16_t* Z = (const bf16_t*)(p.ws + WS_HZ); bf16_t* O = (bf16_t*)(p.ws + WS_A);
    const int row0 = it * 32;
    int seq0, L;
    if (row0 < TCTX) { seq0 = row0 & ~255; L = 256; } else { seq0 = TCTX + ((row0 - TCTX) & ~2047); L = 2048; }
    for (int i = tid; i < 62 * 32; i += NTHREADS) {
        const int rr = i >> 5, ch = (i & 31) * 8;
        const int prow = row0 - 15 + rr;
        f32x4 u0 = {0.f, 0.f, 0.f, 0.f}, u1 = u0;
        if (prow >= seq0 && prow < seq0 + L) {
            const u32x4 a = *(const u32x4*)(Z + (size_t)prow * NIN + 1280 + ch), b = *(const u32x4*)(Z + (size_t)prow * NIN + 1536 + ch);
            u0[0] = bf_lo(a.x) * sigmoid_f(bf_lo(b.x)); u0[1] = bf_hi(a.x) * sigmoid_f(bf_hi(b.x));
            u0[2] = bf_lo(a.y) * sigmoid_f(bf_lo(b.y)); u0[3] = bf_hi(a.y) * sigmoid_f(bf_hi(b.y));
            u1[0] = bf_lo(a.z) * sigmoid_f(bf_lo(b.z)); u1[1] = bf_hi(a.z) * sigmoid_f(bf_hi(b.z));
            u1[2] = bf_lo(a.w) * sigmoid_f(bf_lo(b.w)); u1[3] = bf_hi(a.w) * sigmoid_f(bf_hi(b.w));
        }
        *(LAS f32x4*)(ul + rr * 256 + ch) = u0; *(LAS f32x4*)(ul + rr * 256 + ch + 4) = u1;
    }
    __syncthreads();
    {
        const int c = tid & 255, half = tid >> 8;
        float w[31];
#pragma unroll
        for (int j = 0; j < 31; ++j) w[j] = p.in[19][((size_t)l * 31 + j) * 256 + c];
        const float bias = p.in[20][l * 256 + c];
        float uu[46];
#pragma unroll
        for (int i = 0; i < 46; ++i) uu[i] = ul[(half * 16 + i) * 256 + c];
#pragma unroll
        for (int pp = 0; pp < 16; ++pp) {
            float acc = bias;
#pragma unroll
            for (int j = 0; j < 31; ++j) acc += w[j] * uu[pp + j];
            res[(half * 16 + pp) * 256 + c] = acc;
        }
    }
    __syncthreads();
    {
        const f32x4 g = *(const f32x4*)(p.in[21] + l * 256 + lane * 4), b = *(const f32x4*)(p.in[22] + l * 256 + lane * 4);
#pragma unroll
        for (int r = 0; r < 4; ++r) {
            const int pp = wave * 4 + r;
            f32x4 x = *(const LAS f32x4*)(res + pp * 256 + lane * 4);
            const float mean = wave_sum((x[0] + x[1]) + (x[2] + x[3])) * (1.0f / 256.0f);
            x = x - mean;
            const float var = wave_sum((x[0] * x[0] + x[1] * x[1]) + (x[2] * x[2] + x[3] * x[3])) * (1.0f / 256.0f);
            const float rstd = 1.0f / sqrtf(var + 1e-5f);
            x = x * rstd * g + b;
            u32x2 w; w.x = cvt_pk(silu_f(x[0]), silu_f(x[1])); w.y = cvt_pk(silu_f(x[2]), silu_f(x[3]));
            *(u32x2*)(O + (size_t)(row0 + pp) * D + 256 + lane * 4) = w;
        }
    }
}

template <int NQ>
__device__ __forceinline__ void attn_item(const bf16_t* Qb, const bf16_t* Kp, const bf16_t* Vp, int Lk, int qrow0, int kvh, bf16_t* O, LAS unsigned char* lds) {
    const int tid = otid(), lane = tid & 63, wave = tid >> 6;
    const int g = wave >> 1, sub = wave & 1, head = kvh * 4 + g;
    const int qr = lane & 15, kq = lane >> 4;
    bf16x8 qf[NQ][2];
#pragma unroll
    for (int qi = 0; qi < NQ; ++qi) {
        const int row = qrow0 + sub * (16 * NQ) + qi * 16 + qr;
#pragma unroll
        for (int ks = 0; ks < 2; ++ks) qf[qi][ks] = *(const bf16x8*)(Qb + (size_t)row * 512 + head * 64 + ks * 32 + kq * 8);
    }
    f32x4 o[NQ][4]; float mrun[NQ], lsum[NQ];
#pragma unroll
    for (int qi = 0; qi < NQ; ++qi) { mrun[qi] = -1e30f; lsum[qi] = 0.f;
#pragma unroll
        for (int dt = 0; dt < 4; ++dt) o[qi][dt] = (f32x4){0.f, 0.f, 0.f, 0.f}; }
    const int skey = tid >> 3, sch = tid & 7;
    const int ntile = Lk >> 6;
    u32x4 rk = *(const u32x4*)(Kp + (size_t)skey * 64 + sch * 8), rv = *(const u32x4*)(Vp + (size_t)skey * 64 + sch * 8);
#define AT_KBUF(b) (lds + (b) * 9216)
#define AT_VBUF(b) (lds + 18432 + (b) * 8704)
#define AT_STAGE(b) do { *(LAS u32x4*)(AT_KBUF(b) + skey * 144 + sch * 16) = rk; LAS unsigned short* vt_ = (LAS unsigned short*)(AT_VBUF(b) + (sch * 8) * 136 + skey * 2); \
        vt_[0 * 68] = (unsigned short)(rv.x & 0xffffu); vt_[1 * 68] = (unsigned short)(rv.x >> 16); vt_[2 * 68] = (unsigned short)(rv.y & 0xffffu); vt_[3 * 68] = (unsigned short)(rv.y >> 16); \
        vt_[4 * 68] = (unsigned short)(rv.z & 0xffffu); vt_[5 * 68] = (unsigned short)(rv.z >> 16); vt_[6 * 68] = (unsigned short)(rv.w & 0xffffu); vt_[7 * 68] = (unsigned short)(rv.w >> 16); } while (0)
    AT_STAGE(0);
    __syncthreads();
    for (int kt = 0; kt < ntile; ++kt) {
        const int cur = kt & 1;
        if (kt + 1 < ntile) { rk = *(const u32x4*)(Kp + (size_t)((kt + 1) * 64 + skey) * 64 + sch * 8); rv = *(const u32x4*)(Vp + (size_t)((kt + 1) * 64 + skey) * 64 + sch * 8); }
        f32x4 s[NQ][4];
        const LAS unsigned char* kb = AT_KBUF(cur);
#pragma unroll
        for (int t4 = 0; t4 < 4; ++t4) {
            const bf16x8 ka0 = *(const LAS bf16x8*)(kb + (t4 * 16 + qr) * 144 + kq * 16);
            const bf16x8 ka1 = *(const LAS bf16x8*)(kb + (t4 * 16 + qr) * 144 + 64 + kq * 16);
#pragma unroll
            for (int qi = 0; qi < NQ; ++qi) {
                f32x4 z = {0.f, 0.f, 0.f, 0.f};
                z = __builtin_amdgcn_mfma_f32_16x16x32_bf16(ka0, qf[qi][0], z, 0, 0, 0);
                s[qi][t4] = __builtin_amdgcn_mfma_f32_16x16x32_bf16(ka1, qf[qi][1], z, 0, 0, 0);
            }
        }
        bf16x8 pb[NQ][2];
#pragma unroll
        for (int qi = 0; qi < NQ; ++qi) {
            float mx = -1e30f;
#pragma unroll
            for (int t4 = 0; t4 < 4; ++t4) mx = fmaxf(mx, fmaxf(fmaxf(s[qi][t4][0], s[qi][t4][1]), fmaxf(s[qi][t4][2], s[qi][t4][3])));
            mx = fmaxf(mx, __shfl_xor(mx, 16)); mx = fmaxf(mx, __shfl_xor(mx, 32));
            const float mnew = fmaxf(mrun[qi], mx);
            const float alpha = __builtin_amdgcn_exp2f(mrun[qi] - mnew);
            mrun[qi] = mnew;
            float psum = 0.f;
#pragma unroll
            for (int t4 = 0; t4 < 4; ++t4)
#pragma unroll
                for (int j = 0; j < 4; ++j) { const float pv = __builtin_amdgcn_exp2f(s[qi][t4][j] - mnew); s[qi][t4][j] = pv; psum += pv; }
            lsum[qi] = lsum[qi] * alpha + psum;
#pragma unroll
            for (int dt = 0; dt < 4; ++dt) o[qi][dt] = o[qi][dt] * alpha;
#pragma unroll
            for (int kp = 0; kp < 2; ++kp) {
                u32x4 w; w.x = cvt_pk_c(s[qi][2 * kp][0], s[qi][2 * kp][1]); w.y = cvt_pk_c(s[qi][2 * kp][2], s[qi][2 * kp][3]);
                w.z = cvt_pk_c(s[qi][2 * kp + 1][0], s[qi][2 * kp + 1][1]); w.w = cvt_pk_c(s[qi][2 * kp + 1][2], s[qi][2 * kp + 1][3]);
                pb[qi][kp] = __builtin_bit_cast(bf16x8, w);
            }
        }
        const LAS unsigned char* vb = AT_VBUF(cur);
#pragma unroll
        for (int dt = 0; dt < 4; ++dt)
#pragma unroll
            for (int kp = 0; kp < 2; ++kp) {
                const u32x2 lo = *(const LAS u32x2*)(vb + (dt * 16 + qr) * 136 + ((2 * kp) * 16 + kq * 4) * 2);
                const u32x2 hi = *(const LAS u32x2*)(vb + (dt * 16 + qr) * 136 + ((2 * kp + 1) * 16 + kq * 4) * 2);
                const u32x4 w = {lo.x, lo.y, hi.x, hi.y};
                const bf16x8 va = __builtin_bit_cast(bf16x8, w);
#pragma unroll
                for (int qi = 0; qi < NQ; ++qi) o[qi][dt] = __builtin_amdgcn_mfma_f32_16x16x32_bf16(va, pb[qi][kp], o[qi][dt], 0, 0, 0);
            }
        if (kt + 1 < ntile) AT_STAGE(cur ^ 1);
        __syncthreads();
    }
#undef AT_STAGE
#undef AT_KBUF
#undef AT_VBUF
#pragma unroll
    for (int qi = 0; qi < NQ; ++qi) {
        float ls = lsum[qi]; ls += __shfl_xor(ls, 16); ls += __shfl_xor(ls, 32);
        const float inv = 1.0f / ls;
        const int row = qrow0 + sub * (16 * NQ) + qi * 16 + qr;
#pragma unroll
        for (int dt = 0; dt < 4; ++dt) {
            const f32x4 v = o[qi][dt] * inv;
            u32x2 w; w.x = cvt_pk_c(v[0], v[1]); w.y = cvt_pk_c(v[2], v[3]);
            *(u32x2*)(O + (size_t)row * D + 512 + head * 64 + dt * 16 + kq * 4) = w;
        }
    }
}

__device__ __forceinline__ void mix_a(const Params& p, int l, unsigned* ctr, LAS unsigned char* lds) {
    LAS int* slot = (LAS int*)(lds + LDS_BYTES - 64);
    constexpr int N_HL = 64, N_HC = 1024, N_CV = 384, N_PR = 192, N_PC = 8, TOT = N_HL + N_HC + N_CV + N_PR + N_PC;
    int qk = 0;
    for (;;) {
        int it = next_item(ctr, slot, qk);
        if (it >= TOT) break;
        if (it < N_HL) { const int eg = it & 3, dir = (it >> 2) & 1, h = (it >> 3) & 3, b = it >> 5; hgrn_item(p, l, 2048, TCTX + b * 2048, b, true, h, dir, eg, lds); continue; }
        it -= N_HL;
        if (it < N_HC) { const int eg = it & 3, dir = (it >> 2) & 1, h = (it >> 3) & 3, s = it >> 5; hgrn_item(p, l, 256, s * 256, s, false, h, dir, eg, lds); continue; }
        it -= N_HC;
        if (it < N_CV) { conv_item(p, l, it, lds); continue; }
        it -= N_CV;
        if (it < N_PR) { prep_item(p, l, it); continue; }
        it -= N_PR;
        prepc_item(p, l, it);
    }
}
__device__ __forceinline__ void mix_b(const Params& p, int l, unsigned* ctr, LAS unsigned char* lds) {
    LAS int* slot = (LAS int*)(lds + LDS_BYTES - 64);
    constexpr int N_AL = 256, N_AC = 256, N_HF = 192, TOT = N_AL + N_AC + N_HF;
    const bf16_t* Qb = (const bf16_t*)(p.ws + WS_Q); const bf16_t* Kb = (const bf16_t*)(p.ws + WS_K); const bf16_t* Vb = (const bf16_t*)(p.ws + WS_V);
    bf16_t* O = (bf16_t*)(p.ws + WS_A);
    int qk = 0;
    for (;;) {
        int it = next_item(ctr, slot, qk);
        if (it >= TOT) break;
        if (it < N_AL) {
            const int qt = it & 63, kvh = (it >> 6) & 1, b = it >> 7;
            const size_t off = (size_t)KV_LAT_OFF + (size_t)(b * 2 + kvh) * 2560 * 64;
            if (EN_MASK & 64) attn_item<1>(Qb, Kb + off, Vb + off, 2560, TCTX + b * 2048 + qt * 32, kvh, O, lds);
            continue;
        }
        it -= N_AL;
        if (it < N_AC) {
            const int qt = it & 3, kvh = (it >> 2) & 1, s = it >> 3;
            const size_t off = (size_t)(s * 2 + kvh) * 256 * 64;
            if (EN_MASK & 128) attn_item<2>(Qb, Kb + off, Vb + off, 256, s * 256 + qt * 64, kvh, O, lds);
            continue;
        }
        it -= N_AC;
        if (EN_MASK & 256) hfin_item(p, l, it);
    }
}

__global__ void __launch_bounds__(NTHREADS, 2) fwd_megakernel(Params p) {
    extern __shared__ __attribute__((aligned(16))) unsigned char lds_raw[];
    LAS unsigned char* lds = (LAS unsigned char*)lds_raw;
    cg::grid_group grid = cg::this_grid();
#define GSYNC() do { asm volatile("s_waitcnt vmcnt(0) lgkmcnt(0)" ::: "memory"); grid.sync(); __builtin_amdgcn_fence(__ATOMIC_ACQUIRE, "agent"); asm volatile("s_waitcnt vmcnt(0)" ::: "memory"); } while (0)
    const int G = gridDim.x, c = blockIdx.x;
    unsigned* ctl = (unsigned*)(p.ws + WS_CTL);
    float* X = (float*)(p.ws + WS_X);
    const bf16_t* A = (const bf16_t*)(p.ws + WS_A);
    bf16_t* HZ = (bf16_t*)(p.ws + WS_HZ);
    const float* MOD = (const float*)(p.ws + WS_MOD);

    if (EN_MASK & 32) prologue(p, lds);
    GSYNC();
    init_rows(p);
    GSYNC();
#pragma unroll 1
    for (int l = 0; l < 2; ++l) {
        const unsigned char* wl = p.ws + WS_W + (size_t)l * W_LAYER;
        const float* modl = MOD + (size_t)l * 3 * NMOD;
        { pg8::Gemm g{A, (const bf16_t*)(wl + W_1IN), T, 2 * DFF, D}; pg8::StaticOrder S; S.init(T, 2 * DFF, G, c); EpiSwiglu E{HZ};
          if (EN_MASK & 1) pg8::gemm_phase<EpiSwiglu, pg8::StaticOrder, true, true>(lds, g, S, E); }
        GSYNC();
        { pg8::Gemm g{HZ, (const bf16_t*)(wl + W_1OUT), T, D, DFF}; pg8::StaticOrder S; S.init(T, D, G, c); EpiResid E{X, modl + 2 * 1024, 0.5f};
          if (EN_MASK & 2) pg8::gemm_phase<EpiResid, pg8::StaticOrder, true, true>(lds, g, S, E); }
        GSYNC();
        ln_rows(p, p.in[9] + (size_t)(l * 3 + 0) * D, p.in[10] + (size_t)(l * 3 + 0) * D, modl, 3, nullptr);
        GSYNC();
        { pg8::Gemm g{A, (const bf16_t*)(wl + W_IN), T, NIN, D}; pg8::StaticOrder S; S.init(T, NIN, G, c); EpiZ E{HZ, NIN};
          if (EN_MASK & 4) pg8::gemm_phase<EpiZ, pg8::StaticOrder, true, true>(lds, g, S, E); }
        GSYNC();
        if (EN_MASK & 8) mix_a(p, l, ctl + 64 * (2 * l), lds);
        GSYNC();
        if (EN_MASK & 16) mix_b(p, l, ctl + 64 * (2 * l + 1), lds);
        GSYNC();
        { pg8::Gemm g{A, (const bf16_t*)(wl + W_OUT), T, D, D}; pg8::StaticOrder S; S.init(T, D, G, c); EpiResid E{X, modl + 5 * 1024, 1.0f};
          if (EN_MASK & 2) pg8::gemm_phase<EpiResid, pg8::StaticOrder, true, true>(lds, g, S, E); }
        GSYNC();
        ln_rows(p, p.in[9] + (size_t)(l * 3 + 1) * D, p.in[10] + (size_t)(l * 3 + 1) * D, modl, 6, nullptr);
        GSYNC();
        { pg8::Gemm g{A, (const bf16_t*)(wl + W_2IN), T, 2 * DFF, D}; pg8::StaticOrder S; S.init(T, 2 * DFF, G, c); EpiSwiglu E{HZ};
          if (EN_MASK & 1) pg8::gemm_phase<EpiSwiglu, pg8::StaticOrder, true, true>(lds, g, S, E); }
        GSYNC();
        { pg8::Gemm g{HZ, (const bf16_t*)(wl + W_2OUT), T, D, DFF}; pg8::StaticOrder S; S.init(T, D, G, c); EpiResid E{X, modl + 8 * 1024, 0.5f};
          if (EN_MASK & 2) pg8::gemm_phase<EpiResid, pg8::StaticOrder, true, true>(lds, g, S, E); }
        GSYNC();
        if (l == 0) {
            ln_rows(p, p.in[9] + (size_t)(l * 3 + 2) * D, p.in[10] + (size_t)(l * 3 + 2) * D, MOD + (size_t)3 * NMOD, 0, nullptr);
            GSYNC();
        } else {
            ln_rows(p, p.in[9] + (size_t)(l * 3 + 2) * D, p.in[10] + (size_t)(l * 3 + 2) * D, MOD, 0, p.out + OUT_Y);
        }
    }
}

extern "C" void kernel_launch(void* const* d_in, const int* in_sizes, int n_in, void* d_out, int out_size, void* d_ws, size_t ws_size, hipStream_t stream) {
    static int grid_blocks = 0;
    if (grid_blocks == 0) {
        if (n_in != 25 || ws_size < WS_END) { fprintf(stderr, "kernel_launch: unexpected n_in %d or ws_size %zu (< %zu)\n", n_in, ws_size, (size_t)WS_END); grid_blocks = -1; return; }
        int dev = 0, cus = 0, per_cu = 0;
        hipGetDevice(&dev);
        hipDeviceGetAttribute(&cus, hipDeviceAttributeMultiprocessorCount, dev);
        if (hipFuncSetAttribute((const void*)fwd_megakernel, hipFuncAttributeMaxDynamicSharedMemorySize, LDS_BYTES) != hipSuccess) { fprintf(stderr, "kernel_launch: hipFuncSetAttribute failed\n"); grid_blocks = -1; return; }
        if (hipOccupancyMaxActiveBlocksPerMultiprocessor(&per_cu, (const void*)fwd_megakernel, NTHREADS, LDS_BYTES) != hipSuccess || per_cu < 1) { fprintf(stderr, "kernel_launch: occupancy query failed (%d)\n", per_cu); per_cu = 1; }
        (void)hipGetLastError();
        grid_blocks = cus * per_cu;
    }
    if (grid_blocks < 0) return;
    hipMemsetAsync((char*)d_ws + WS_CTL, 0, CTL_BYTES, stream);
    Params p{};
    for (int i = 0; i < 25; ++i) p.in[i] = (const float*)d_in[i];
    p.out = (float*)d_out; p.ws = (unsigned char*)d_ws;
    void* args[] = {&p};
    hipError_t e = hipLaunchCooperativeKernel((const void*)fwd_megakernel, dim3(grid_blocks), dim3(NTHREADS), args, LDS_BYTES, stream);
    if (e != hipSuccess) fprintf(stderr, "cooperative launch failed: %s (grid %d)\n", hipGetErrorString(e), grid_blocks);
}
```

```cpp
#include <hip/hip_runtime.h>
#include <hip/hip_cooperative_groups.h>
#include <cstdio>
#include <cstdint>
namespace cg = cooperative_groups;
namespace pg8 {
#define PG8_LAS __attribute__((address_space(3)))
typedef unsigned short bf16_t;
typedef short bf16x8 __attribute__((ext_vector_type(8)));
typedef float f32x4 __attribute__((ext_vector_type(4)));
typedef unsigned u32x4 __attribute__((ext_vector_type(4)));
constexpr int BM = 256, BK = 64, HALF = 128, HTB = HALF * BK * 2  , STAGE_BYTES = 8 * HTB, NXCD = 8, WGM = 8;

__host__ __device__ __forceinline__ int lds_byte(int r, int c) { const int st = (r >> 4) * 2 + (c >> 5), rr = r & 15, cc = c & 31, ob = rr * 64 + cc * 2; return st * 1024 + (ob ^ (((ob >> 9) & 1) << 5)); }
__host__ __device__ __forceinline__ void stage_rc(int b, int& R, int& C) { const int st = b / 1024, sb = b % 1024, swz = sb ^ (((sb >> 9) & 1) << 5); R = (st >> 1) * 16 + swz / 64; C = (st & 1) * 32 + (swz % 64) / 2; }
__host__ __device__ __forceinline__ int perm32(int rho) { const int n = rho >> 4, i = rho & 15; return 8 * (i >> 2) + 4 * n + (i & 3); }

struct Unit { int pm, pn; };
struct Gemm { const bf16_t* A; const bf16_t* Bt; int M, N, K; };

struct StaticOrder {
    int nM, nN, nwg, G, c;
    __host__ __device__ void init(int M, int N, int G_, int c_) { nM = M / BM; nN = N / BM; nwg = nM * nN; G = G_; c = c_; }
    __host__ __device__ bool next(int i, Unit& u) const {
        const long L = (long)i * G + c; if (L >= nwg) return false;
        int wgid = (int)L; { const int q = nwg / NXCD, r = nwg % NXCD, xcd = wgid % NXCD, off = wgid / NXCD; wgid = (xcd < r ? xcd * (q + 1) : r * (q + 1) + (xcd - r) * q) + off; }
        const int nig = WGM * nN, gid = wgid / nig, fm = gid * WGM, gsz = (nM - fm) < WGM ? (nM - fm) : WGM;
        u.pm = fm + ((wgid % nig) % gsz); u.pn = (wgid % nig) / gsz; return true;
    }
    __device__ __forceinline__ void a_ready(const Unit&) const {}
    __device__ __forceinline__ void done(const Unit&) const {}
};
__device__ __forceinline__ unsigned cvt_pk_bf16(float lo, float hi) { unsigned r; asm volatile("v_cvt_pk_bf16_f32 %0, %1, %2" : "=v"(r) : "v"(lo), "v"(hi)); return r; }
template <class Epi, class Sched, bool ALIGN_EPI = false, bool SP2 = false>
__device__ __forceinline__ void gemm_phase(PG8_LAS unsigned char* lds, const Gemm g, const Sched& S, const Epi& E) {
    int tid_o = threadIdx.x; asm volatile("" : "+v"(tid_o)); const int tid = tid_o, wid = __builtin_amdgcn_readfirstlane(tid >> 6), lane = tid & 63, wr = wid >> 2, wc = wid & 3, fr = lane & 15, fq = lane >> 4;
    const int K = g.K, nt = K / BK;
    unsigned voffA[2], voffB[2];
#pragma unroll
    for (int i = 0; i < 2; ++i) { int R, C; stage_rc(tid * 16 + i * 8192, R, C); const int Rb = Epi::PERM ? ((R & ~31) + perm32(R & 31)) : R;
        voffA[i] = (unsigned)(R * K + C) * 2u; voffB[i] = (unsigned)(Rb * K + C) * 2u; }
    const size_t kstep = (size_t)(BK * 2);
    const size_t hstep = (size_t)HALF * K * 2;
    const size_t tstep = 2 * hstep;
    const unsigned ldsw = (unsigned)wid * 1024u;
    const int aoff = lds_byte(wr * 64 + fr, fq * 8), boff = lds_byte(wc * 32 + fr, fq * 8);
#define PG8_SA(b, h) (((b) * 2 + (h)) * HTB)
#define PG8_SB(b, h) ((4 + (b) * 2 + (h)) * HTB)
#define PG8_STAGE(bufoff, gbase, voff) do { _Pragma("unroll") for (int _i = 0; _i < 2; ++_i) \
        __builtin_amdgcn_global_load_lds((const unsigned*)((const char*)(gbase) + (voff)[_i]), (PG8_LAS unsigned*)(lds + (bufoff) + ldsw + _i * 8192), 16, 0, 0); } while (0)
#define PG8_LDA(dst, b, h) do { _Pragma("unroll") for (int m = 0; m < 4; ++m) _Pragma("unroll") for (int k = 0; k < 2; ++k) dst[m][k] = *(const PG8_LAS bf16x8*)(lds + PG8_SA(b, h) + aoff + m * 2048 + k * 1024); } while (0)
#define PG8_LDB(dst, b, h) do { _Pragma("unroll") for (int n = 0; n < 2; ++n) _Pragma("unroll") for (int k = 0; k < 2; ++k) dst[n][k] = *(const PG8_LAS bf16x8*)(lds + PG8_SB(b, h) + boff + n * 2048 + k * 1024); } while (0)
#define PG8_MMA(ai, bj, At, Bt) do { __builtin_amdgcn_s_setprio(1); _Pragma("unroll") for (int m = 0; m < 4; ++m) _Pragma("unroll") for (int n = 0; n < 2; ++n) _Pragma("unroll") for (int k = 0; k < 2; ++k) \
        acc[ai][bj][m][n] = __builtin_amdgcn_mfma_f32_16x16x32_bf16(Bt[n][k], At[m][k], acc[ai][bj][m][n], 0, 0, 0); __builtin_amdgcn_s_setprio(0); } while (0)
#define PG8_WAIT_V(n) asm volatile("s_waitcnt vmcnt(" #n ")" ::: "memory")
#define PG8_WAIT_L(n) asm volatile("s_waitcnt lgkmcnt(" #n ")" ::: "memory")
#define PG8_BAR __builtin_amdgcn_s_barrier()
#define PG8_SCHED __builtin_amdgcn_sched_barrier(0)
    Unit cur, nxt; int ui = 0;
    if (!S.next(0, cur)) return;
    f32x4 acc[2][2][4][2];
#pragma unroll
    for (int a = 0; a < 2; ++a)
#pragma unroll
        for (int b = 0; b < 2; ++b)
#pragma unroll
            for (int m = 0; m < 4; ++m)
#pragma unroll
                for (int n = 0; n < 2; ++n) acc[a][b][m][n] = (f32x4){0.f, 0.f, 0.f, 0.f};
    bf16x8 At[4][2], B0[2][2], B1[2][2];
    const char* cA = (const char*)g.A + (size_t)cur.pm * tstep; const char* cB = (const char*)g.Bt + (size_t)cur.pn * tstep;
    S.a_ready(cur);
    if constexpr (SP2) {
        PG8_STAGE(PG8_SB(0, 0), cB, voffB); PG8_STAGE(PG8_SB(0, 1), cB + hstep, voffB); PG8_STAGE(PG8_SA(0, 0), cA, voffA); PG8_STAGE(PG8_SA(0, 1), cA + hstep, voffA);
        if (wr == 1) PG8_BAR;
        PG8_WAIT_V(2); PG8_BAR;
        PG8_STAGE(PG8_SB(1, 0), cB + kstep, voffB); PG8_STAGE(PG8_SA(1, 0), cA + kstep, voffA); PG8_STAGE(PG8_SB(1, 1), cB + hstep + kstep, voffB);
        PG8_WAIT_V(6); PG8_BAR;
    } else {
        PG8_STAGE(PG8_SB(0, 0), cB, voffB); PG8_STAGE(PG8_SA(0, 0), cA, voffA); PG8_STAGE(PG8_SB(0, 1), cB + hstep, voffB); PG8_STAGE(PG8_SA(0, 1), cA + hstep, voffA);
        if (wr == 1) PG8_BAR;
        PG8_WAIT_V(4); PG8_BAR;
        PG8_STAGE(PG8_SB(1, 0), cB + kstep, voffB); PG8_STAGE(PG8_SA(1, 0), cA + kstep, voffA); PG8_STAGE(PG8_SB(1, 1), cB + hstep + kstep, voffB);
        PG8_WAIT_V(6); PG8_BAR;
    }
    for (;;) {
        const bool has_next = S.next(ui + 1, nxt);
        const char* nA = has_next ? (const char*)g.A + (size_t)nxt.pm * tstep : cA; const char* nB = has_next ? (const char*)g.Bt + (size_t)nxt.pn * tstep : cB;
        for (int t = 0; t < nt; t += 2) {
            const bool last = (t == nt - 2);
            const char* a1 = cA + (size_t)(t + 1) * kstep;
            const char* a2 = last ? nA : cA + (size_t)(t + 2) * kstep; const char* b2 = last ? nB : cB + (size_t)(t + 2) * kstep;
            const char* a3 = a2 + kstep; const char* b3 = b2 + kstep;
            if (last && has_next) S.a_ready(nxt);
            if constexpr (SP2) {
            PG8_LDB(B0, 0, 0); PG8_LDB(B1, 0, 1); PG8_SCHED; PG8_LDA(At, 0, 0); PG8_STAGE(PG8_SA(1, 1), a1 + hstep, voffA);
            PG8_WAIT_V(8); PG8_WAIT_L(0); PG8_BAR; PG8_MMA(0, 0, At, B0); PG8_MMA(0, 1, At, B1); PG8_BAR; PG8_SCHED;
            PG8_LDA(At, 0, 1); PG8_STAGE(PG8_SB(0, 0), b2, voffB); PG8_STAGE(PG8_SB(0, 1), b2 + hstep, voffB); PG8_STAGE(PG8_SA(0, 0), a2, voffA);
            PG8_WAIT_V(8); PG8_WAIT_L(0); PG8_BAR; PG8_MMA(1, 0, At, B0); PG8_MMA(1, 1, At, B1); PG8_BAR; PG8_SCHED;
            PG8_LDB(B0, 1, 0); PG8_LDB(B1, 1, 1); PG8_SCHED; PG8_LDA(At, 1, 0); PG8_STAGE(PG8_SA(0, 1), a2 + hstep, voffA);
            PG8_WAIT_V(8); PG8_WAIT_L(0); PG8_BAR; PG8_MMA(0, 0, At, B0); PG8_MMA(0, 1, At, B1); PG8_BAR; PG8_SCHED;
            PG8_LDA(At, 1, 1); PG8_STAGE(PG8_SB(1, 0), b3, voffB); PG8_STAGE(PG8_SB(1, 1), b3 + hstep, voffB); PG8_STAGE(PG8_SA(1, 0), a3, voffA);
            PG8_WAIT_V(8); PG8_WAIT_L(0); PG8_BAR; PG8_MMA(1, 0, At, B0); PG8_MMA(1, 1, At, B1); PG8_BAR; PG8_SCHED;
            } else {
            PG8_LDB(B0, 0, 0); PG8_SCHED; PG8_LDA(At, 0, 0); PG8_STAGE(PG8_SA(1, 1), a1 + hstep, voffA);
            PG8_WAIT_L(8); PG8_BAR; PG8_WAIT_L(0); PG8_MMA(0, 0, At, B0); PG8_BAR; PG8_SCHED;
            PG8_LDB(B1, 0, 1); PG8_STAGE(PG8_SB(0, 0), b2, voffB);
            PG8_BAR; PG8_WAIT_L(0); PG8_MMA(0, 1, At, B1); PG8_BAR;
            PG8_LDA(At, 0, 1); PG8_STAGE(PG8_SA(0, 0), a2, voffA);
            PG8_BAR; PG8_WAIT_L(0); PG8_MMA(1, 0, At, B0); PG8_BAR; PG8_SCHED;
            PG8_STAGE(PG8_SB(0, 1), b2 + hstep, voffB);
            PG8_WAIT_V(6); PG8_BAR; PG8_MMA(1, 1, At, B1); PG8_BAR;
            PG8_LDB(B0, 1, 0); PG8_SCHED; PG8_LDA(At, 1, 0); PG8_STAGE(PG8_SA(0, 1), a2 + hstep, voffA);
            PG8_WAIT_L(8); PG8_BAR; PG8_WAIT_L(0); PG8_MMA(0, 0, At, B0); PG8_BAR; PG8_SCHED;
            PG8_LDB(B1, 1, 1); PG8_STAGE(PG8_SB(1, 0), b3, voffB);
            PG8_BAR; PG8_WAIT_L(0); PG8_MMA(0, 1, At, B1); PG8_BAR;
            PG8_LDA(At, 1, 1); PG8_STAGE(PG8_SA(1, 0), a3, voffA);
            PG8_BAR; PG8_WAIT_L(0); PG8_MMA(1, 0, At, B0); PG8_BAR; PG8_SCHED;
            PG8_STAGE(PG8_SB(1, 1), b3 + hstep, voffB);
            PG8_WAIT_V(6); PG8_BAR; PG8_MMA(1, 1, At, B1); PG8_BAR;
            }
        }
        if constexpr (ALIGN_EPI) { if (wr == 0) PG8_BAR; }
        if constexpr (!Epi::AFTER_DRAIN) { E(acc, cur, wr, wc, fr, fq); S.done(cur); }
        if (!has_next) break;
#pragma unroll
        for (int a = 0; a < 2; ++a)
#pragma unroll
            for (int b = 0; b < 2; ++b)
#pragma unroll
                for (int m = 0; m < 4; ++m)
#pragma unroll
                    for (int n = 0; n < 2; ++n) acc[a][b][m][n] = (f32x4){0.f, 0.f, 0.f, 0.f};
        cur = nxt; cA = nA; cB = nB; ++ui;
        if constexpr (ALIGN_EPI) { if (wr == 1) PG8_BAR; }
    }
    PG8_WAIT_V(0);
    if constexpr (!ALIGN_EPI) { if (wr == 0) PG8_BAR; }
    PG8_BAR;
    if constexpr (Epi::AFTER_DRAIN) { E.fused(acc, cur, wr, wc, fr, fq, lds, wid, lane); S.done(cur); }
#undef PG8_SA
#undef PG8_SB
#undef PG8_STAGE
#undef PG8_LDA
#undef PG8_LDB
#undef PG8_MMA
#undef PG8_WAIT_V
#undef PG8_WAIT_L
#undef PG8_BAR
#undef PG8_SCHED
}
}

#define LAS __attribute__((address_space(3)))
typedef unsigned short bf16_t;
typedef short bf16x8 __attribute__((ext_vector_type(8)));
typedef float f32x4 __attribute__((ext_vector_type(4)));
typedef float f32x2 __attribute__((ext_vector_type(2)));
typedef unsigned u32x4 __attribute__((ext_vector_type(4)));
typedef unsigned u32x2 __attribute__((ext_vector_type(2)));

constexpr int D = 1024, DFF = 2816, NIN = 2560, T = 12288, TCTX = 8192;
constexpr int NMOD = 9216;
constexpr float ALPHA = 1.41421356237309515f;
constexpr float QSCALE = 0.125f * 1.44269504088896341f;
constexpr int NTHREADS = 512, NWAVES = 8;
constexpr int LDS_BYTES = 147456;
#ifndef EN_MASK
#define EN_MASK 0xFFFF
#endif
#ifndef REP_MASK
#define REP_MASK 0
#endif

constexpr size_t MiB = 1u << 20;
constexpr size_t WS_CTL = 0, CTL_BYTES = 65536;
constexpr size_t WS_MOD = 65536;
constexpr size_t WS_ROPE = 524288;
constexpr size_t WS_W = 2 * MiB, W_LAYER = 40 * MiB;
constexpr size_t W_1IN = 0, W_1OUT = 11 * MiB, W_2IN = 16 * MiB + MiB / 2, W_2OUT = 27 * MiB + MiB / 2, W_IN = 33 * MiB, W_OUT = 38 * MiB;
constexpr size_t WS_X = 82 * MiB;
constexpr size_t WS_A = 130 * MiB;
constexpr size_t WS_HZ = 154 * MiB;
constexpr size_t WS_Q = 220 * MiB;
constexpr size_t WS_K = 232 * MiB, WS_V = 236 * MiB;
constexpr size_t WS_OH = 240 * MiB;
constexpr size_t WS_END = 264 * MiB;
constexpr int KV_LAT_OFF = 32 * 2 * 256 * 64;
constexpr size_t OUT_Y = 0, OUT_CK = (size_t)T * D, OUT_CV = OUT_CK + 2097152, OUT_ST = OUT_CV + 2097152;

struct Params { const float* in[25]; float* out; unsigned char* ws; };

__device__ __forceinline__ unsigned cvt_pk(float lo, float hi) { unsigned r; asm("v_cvt_pk_bf16_f32 %0, %1, %2" : "=v"(r) : "v"(lo), "v"(hi)); return r; }
typedef __bf16 bf16x2_t __attribute__((ext_vector_type(2)));
__device__ __forceinline__ unsigned cvt_pk_c(float lo, float hi) { unsigned r; asm volatile("v_cvt_pk_bf16_f32 %0, %1, %2\n\ts_nop 1" : "=v"(r) : "v"(lo), "v"(hi)); return r; }
__device__ __forceinline__ float bf_lo(unsigned u) { return __uint_as_float(u << 16); }
__device__ __forceinline__ float bf_hi(unsigned u) { return __uint_as_float(u & 0xffff0000u); }
__device__ __forceinline__ float silu_f(float x) { return x / (1.0f + __expf(-x)); }
__device__ __forceinline__ float sigmoid_f(float x) { return 1.0f / (1.0f + __expf(-x)); }
__device__ __forceinline__ float wave_sum(float v) {
#pragma unroll
    for (int o = 1; o < 64; o <<= 1) v += __shfl_xor(v, o);
    return v;
}
__device__ __forceinline__ int otid() { int t = threadIdx.x; asm volatile("" : "+v"(t)); return t; }
__device__ __forceinline__ int cond_of_row(int row) { return row < TCTX ? 0 : 1 + ((row - TCTX) >> 11); }

struct EpiSwiglu {
    static constexpr bool PERM = true, AFTER_DRAIN = false;
    bf16_t* H;
    __device__ __forceinline__ void operator()(const pg8::f32x4 (&acc)[2][2][4][2], const pg8::Unit& u, int wr, int wc, int fr, int fq) const {
        const int row0 = u.pm * 256 + wr * 64 + fr, col0 = u.pn * 128 + wc * 32 + 8 * fq;
#pragma unroll
        for (int ai = 0; ai < 2; ++ai)
#pragma unroll
            for (int m = 0; m < 4; ++m) {
                bf16_t* rowp = H + (size_t)(row0 + ai * 128 + m * 16) * DFF + col0;
                float h[8];
#pragma unroll
                for (int n = 0; n < 2; ++n)
#pragma unroll
                    for (int i = 0; i < 4; ++i) { const float g = acc[ai][0][m][n][i], up = acc[ai][1][m][n][i]; h[n * 4 + i] = silu_f(g) * up; }
                u32x4 w; w.x = cvt_pk(h[0], h[1]); w.y = cvt_pk(h[2], h[3]); w.z = cvt_pk(h[4], h[5]); w.w = cvt_pk(h[6], h[7]);
                *(u32x4*)rowp = w;
            }
    }
};
struct EpiZ {
    static constexpr bool PERM = true, AFTER_DRAIN = false;
    bf16_t* O; int ldc;
    __device__ __forceinline__ void operator()(const pg8::f32x4 (&acc)[2][2][4][2], const pg8::Unit& u, int wr, int wc, int fr, int fq) const {
        const int row0 = u.pm * 256 + wr * 64 + fr, col0 = u.pn * 256 + wc * 32 + 8 * fq;
#pragma unroll
        for (int ai = 0; ai < 2; ++ai)
#pragma unroll
            for (int m = 0; m < 4; ++m) {
                bf16_t* rowp = O + (size_t)(row0 + ai * 128 + m * 16) * ldc + col0;
#pragma unroll
                for (int bj = 0; bj < 2; ++bj) {
                    const pg8::f32x4 v0 = acc[ai][bj][m][0], v1 = acc[ai][bj][m][1];
                    u32x4 w; w.x = cvt_pk(v0[0], v0[1]); w.y = cvt_pk(v0[2], v0[3]); w.z = cvt_pk(v1[0], v1[1]); w.w = cvt_pk(v1[2], v1[3]);
                    *(u32x4*)(rowp + bj * 128) = w;
                }
            }
    }
};
struct EpiResid {
    static constexpr bool PERM = false, AFTER_DRAIN = false;
    float* X; const float* gate; float s;
    __device__ __forceinline__ void operator()(const pg8::f32x4 (&acc)[2][2][4][2], const pg8::Unit& u, int wr, int wc, int fr, int fq) const {
        const int cond = u.pm < 32 ? 0 : 1 + ((u.pm - 32) >> 3);
        const float* gv = gate + cond * NMOD;
        const int row0 = u.pm * 256 + wr * 64 + fr, col0 = u.pn * 256 + wc * 32 + 4 * fq;
#pragma unroll
        for (int bj = 0; bj < 2; ++bj)
#pragma unroll
            for (int n = 0; n < 2; ++n) {
                const int c = col0 + bj * 128 + n * 16;
                const f32x4 g = *(const f32x4*)(gv + c) * s;
#pragma unroll
                for (int ai = 0; ai < 2; ++ai)
#pragma unroll
                    for (int m = 0; m < 4; ++m) {
                        f32x4* px = (f32x4*)(X + (size_t)(row0 + ai * 128 + m * 16) * D + c);
                        const f32x4 xv = *px;
                        *px = xv * ALPHA + g * acc[ai][bj][m][n];
                    }
            }
    }
};

__device__ __forceinline__ void transpose_item(const float* W, int K, int N, bf16_t* WT, int k0, int n0, int dst_row0, LAS float* scr, int lane) {
#pragma unroll 8
    for (int i = 0; i < 32; ++i) { const int kk = 2 * i + (lane >> 5); scr[kk * 33 + (lane & 31)] = W[(size_t)(k0 + kk) * N + n0 + (lane & 31)]; }
    asm volatile("s_waitcnt lgkmcnt(0)" ::: "memory");
    const int c = lane & 7;
#pragma unroll
    for (int j = 0; j < 4; ++j) {
        const int n = (lane >> 3) + 8 * j; const LAS float* s = scr + (8 * c) * 33 + n;
        u32x4 o; o.x = cvt_pk(s[0 * 33], s[1 * 33]); o.y = cvt_pk(s[2 * 33], s[3 * 33]); o.z = cvt_pk(s[4 * 33], s[5 * 33]); o.w = cvt_pk(s[6 * 33], s[7 * 33]);
        *(u32x4*)(WT + (size_t)(dst_row0 + n) * K + k0 + 8 * c) = o;
    }
    asm volatile("s_waitcnt lgkmcnt(0)" ::: "memory");
}
__device__ __forceinline__ int swiglu_row(int n) { return n < DFF ? (n >> 7) * 256 + (n & 127) : ((n - DFF) >> 7) * 256 + 128 + ((n - DFF) & 127); }

__device__ __forceinline__ void mod_item(const Params& p, int it, LAS unsigned char* lds) {
    const int tid = otid();
    LAS float* sl = (LAS float*)lds;
    LAS float* red = sl + 3072;
    const int l = it / 72, cg0 = (it % 72) * 128;
    for (int i = tid; i < 3072; i += NTHREADS) { const int c = i >> 10, k = i & 1023; const float v = c == 0 ? p.in[6][k] : p.in[5][(c - 1) * 1024 + k]; sl[i] = silu_f(v); }
    __syncthreads();
    const int cq = tid & 31, ks = tid >> 5;
    const float* w = p.in[7] + ((size_t)l * 1024 + ks * 64) * NMOD + cg0 + cq * 4;
    f32x4 a0 = {0.f, 0.f, 0.f, 0.f}, a1 = a0, a2 = a0;
#pragma unroll 8
    for (int k = 0; k < 64; ++k) {
        const f32x4 wv = *(const f32x4*)(w + (size_t)k * NMOD); const int kk = ks * 64 + k;
        a0 += wv * sl[kk]; a1 += wv * sl[1024 + kk]; a2 += wv * sl[2048 + kk];
    }
    *(LAS f32x4*)(red + (ks * 3 + 0) * 128 + cq * 4) = a0;
    *(LAS f32x4*)(red + (ks * 3 + 1) * 128 + cq * 4) = a1;
    *(LAS f32x4*)(red + (ks * 3 + 2) * 128 + cq * 4) = a2;
    __syncthreads();
    if (tid < 384) {
        const int c = tid >> 7, col = tid & 127; float s = 0.f;
#pragma unroll
        for (int k = 0; k < 16; ++k) s += red[(k * 3 + c) * 128 + col];
        ((float*)(p.ws + WS_MOD))[(size_t)(l * 3 + c) * NMOD + cg0 + col] = s + p.in[8][(size_t)l * NMOD + cg0 + col];
    }
    __syncthreads();
}

__device__ __forceinline__ void prologue(const Params& p, LAS unsigned char* lds) {
    const int tid = otid(), lane = tid & 63, wave = tid >> 6;
    const int G = gridDim.x;
    for (int it = blockIdx.x; it < 144; it += G) mod_item(p, it, lds);
    if (blockIdx.x == G - 1) {
        float* rc = (float*)(p.ws + WS_ROPE);
        for (int i = tid; i < 1024; i += NTHREADS) {
            const int pos = i >> 4, pp = i & 15;
            const float inv = exp2f(-(float)pp * (13.287712379549449f / 16.0f));
            const float ang = (float)pos * inv;
            rc[i] = cosf(ang); rc[1024 + i] = sinf(ang);
        }
    }
    __syncthreads();
    LAS float* scr = (LAS float*)(lds + wave * 16384);
    const int gw = blockIdx.x * NWAVES + wave, NGW = G * NWAVES;
    for (int it = gw; it < 20480; it += NGW) {
        const int l = it / 10240; int r = it % 10240;
        bf16_t* wl = (bf16_t*)(p.ws + WS_W + (size_t)l * W_LAYER);
        if (r < 5632) {
            const int which = r / 2816; r %= 2816;
            const int kb = r / 176, nb = r % 176;
            const float* W = p.in[which ? 13 : 11] + (size_t)l * 1024 * 5632;
            transpose_item(W, 1024, 5632, (bf16_t*)((unsigned char*)wl + (which ? W_2IN : W_1IN)), kb * 64, nb * 32, swiglu_row(nb * 32), scr, lane);
        } else if (r < 5632 + 2816) {
            r -= 5632; const int which = r / 1408; r %= 1408;
            const int kb = r / 32, nb = r % 32;
            const float* W = p.in[which ? 14 : 12] + (size_t)l * 2816 * 1024;
            transpose_item(W, 2816, 1024, (bf16_t*)((unsigned char*)wl + (which ? W_2OUT : W_1OUT)), kb * 64, nb * 32, nb * 32, scr, lane);
        } else if (r < 5632 + 2816 + 1280) {
            r -= 5632 + 2816; const int kb = r / 80, nb = r % 80;
            transpose_item(p.in[15] + (size_t)l * 1024 * 2560, 1024, 2560, (bf16_t*)((unsigned char*)wl + W_IN), kb * 64, nb * 32, nb * 32, scr, lane);
        } else {
            r -= 5632 + 2816 + 1280; const int kb = r / 32, nb = r % 32;
            transpose_item(p.in[16] + (size_t)l * 1024 * 1024, 1024, 1024, (bf16_t*)((unsigned char*)wl + W_OUT), kb * 64, nb * 32, nb * 32, scr, lane);
        }
    }
}

__device__ __forceinline__ void store_mod_row(bf16_t* arow, const f32x4 (&x)[4], const float* sh, const float* sc, int lane) {
#pragma unroll
    for (int j = 0; j < 4; ++j) {
        const int c = 4 * lane + 256 * j;
        const f32x4 s = *(const f32x4*)(sh + c), k = *(const f32x4*)(sc + c);
        const f32x4 a = x[j] * (k + 1.0f) + s;
        u32x2 w; w.x = cvt_pk(a[0], a[1]); w.y = cvt_pk(a[2], a[3]);
        *(u32x2*)(arow + c) = w;
    }
}
__device__ __forceinline__ void init_rows(const Params& p) {
    const int tid_ = otid(); const int lane = tid_ & 63, wave = tid_ >> 6;
    const int gw = blockIdx.x * NWAVES + wave, NGW = gridDim.x * NWAVES;
    float* X = (float*)(p.ws + WS_X); bf16_t* A = (bf16_t*)(p.ws + WS_A); const float* MOD = (const float*)(p.ws + WS_MOD);
    for (int row = gw; row < T; row += NGW) {
        const float* src = row < TCTX ? p.in[0] + (size_t)row * D : p.in[1] + (size_t)(row - TCTX) * D;
        const int cond = cond_of_row(row);
        f32x4 v[4];
#pragma unroll
        for (int j = 0; j < 4; ++j) { v[j] = *(const f32x4*)(src + 4 * lane + 256 * j); *(f32x4*)(X + (size_t)row * D + 4 * lane + 256 * j) = v[j]; }
        store_mod_row(A + (size_t)row * D, v, MOD + cond * NMOD + 0 * 1024, MOD + cond * NMOD + 1 * 1024, lane);
    }
}
__device__ __forceinline__ void ln_rows(const Params& p, const float* g, const float* b, const float* modn, int shi, float* final_out) {
    const int tid_ = otid(); const int lane = tid_ & 63, wave = tid_ >> 6;
    const int gw = blockIdx.x * NWAVES + wave, NGW = gridDim.x * NWAVES;
    float* X = (float*)(p.ws + WS_X); bf16_t* A = (bf16_t*)(p.ws + WS_A);
    for (int row = gw; row < T; row += NGW) {
        f32x4 v[4]; float s = 0.f;
#pragma unroll
        for (int j = 0; j < 4; ++j) { v[j] = *(const f32x4*)(X + (size_t)row * D + 4 * lane + 256 * j); s += (v[j][0] + v[j][1]) + (v[j][2] + v[j][3]); }
        const float mean = wave_sum(s) * (1.0f / D); float q = 0.f;
#pragma unroll
        for (int j = 0; j < 4; ++j) { v[j] = v[j] - mean; q += (v[j][0] * v[j][0] + v[j][1] * v[j][1]) + (v[j][2] * v[j][2] + v[j][3] * v[j][3]); }
        const float rstd = 1.0f / sqrtf(wave_sum(q) * (1.0f / D) + 1e-5f);
        float* dst = final_out ? final_out + (size_t)row * D : X + (size_t)row * D;
#pragma unroll
        for (int j = 0; j < 4; ++j) {
            const int c = 4 * lane + 256 * j;
            v[j] = v[j] * rstd * *(const f32x4*)(g + c) + *(const f32x4*)(b + c);
            *(f32x4*)(dst + c) = v[j];
        }
        if (!final_out) { const int cond = cond_of_row(row); store_mod_row(A + (size_t)row * D, v, modn + cond * NMOD + shi * 1024, modn + cond * NMOD + (shi + 1) * 1024, lane); }
    }
}

#ifndef STATIC_Q
#define STATIC_Q 1
#endif
__device__ __forceinline__ int next_item(unsigned* ctr, LAS int* slot, int& k) {
    __syncthreads();
#if STATIC_Q
    const int r = blockIdx.x + k * gridDim.x; ++k; return r;
#else
    if (threadIdx.x == 0) *slot = (int)atomicAdd(ctr, 1u);
    __syncthreads();
    return *slot;
#endif
}

__device__ __forceinline__ void prep_item(const Params& p, int l, int it) {
    const int tid_ = otid(); const int lane = tid_ & 63, wave = tid_ >> 6;
    const bf16_t* Z = (const bf16_t*)(p.ws + WS_HZ);
    bf16_t* Qb = (bf16_t*)(p.ws + WS_Q); bf16_t* Kb = (bf16_t*)(p.ws + WS_K); bf16_t* Vb = (bf16_t*)(p.ws + WS_V);
    const float* rc = (const float*)(p.ws + WS_ROPE);
    const int sb = lane & 7;
    float gq[8], gk[8];
#pragma unroll
    for (int i = 0; i < 8; ++i) { gq[i] = p.in[23][l * 64 + sb * 8 + i]; gk[i] = p.in[24][l * 64 + sb * 8 + i]; }
    for (int r8 = 0; r8 < 8; ++r8) {
        const int row = it * 64 + wave * 8 + r8;
        const bool lat = row >= TCTX;
        const int tl = lat ? ((row - TCTX) & 2047) : (row & 255);
        const int pos = (sb < 4) ? (tl >> 6) : (tl & 63);
        float cs[8], sn[8];
#pragma unroll
        for (int i = 0; i < 8; ++i) { cs[i] = rc[pos * 16 + (sb & 1) * 8 + i]; sn[i] = rc[1024 + pos * 16 + (sb & 1) * 8 + i]; }
        {
            const u32x4 z = *(const u32x4*)(Z + (size_t)row * NIN + 1792 + lane * 8);
            float x[8] = {bf_lo(z.x), bf_hi(z.x), bf_lo(z.y), bf_hi(z.y), bf_lo(z.z), bf_hi(z.z), bf_lo(z.w), bf_hi(z.w)};
            float ss = 0.f;
#pragma unroll
            for (int i = 0; i < 8; ++i) ss += x[i] * x[i];
            ss += __shfl_xor(ss, 1); ss += __shfl_xor(ss, 2); ss += __shfl_xor(ss, 4);
            const float rr = 1.0f / sqrtf(ss * (1.0f / 64.0f) + 1e-6f);
#pragma unroll
            for (int i = 0; i < 8; ++i) x[i] = x[i] * rr * gq[i];
#pragma unroll
            for (int i = 0; i < 8; ++i) {
                const float o = __shfl_xor(x[i], 2);
                const float r = (sb & 2) ? x[i] * cs[i] + o * sn[i] : x[i] * cs[i] - o * sn[i];
                x[i] = (lat ? r : x[i]) * QSCALE;
            }
            u32x4 w; w.x = cvt_pk(x[0], x[1]); w.y = cvt_pk(x[2], x[3]); w.z = cvt_pk(x[4], x[5]); w.w = cvt_pk(x[6], x[7]);
            *(u32x4*)(Qb + (size_t)row * 512 + lane * 8) = w;
        }
        {
            const int ln = lane & 31;
            const u32x4 z = *(const u32x4*)(Z + (size_t)row * NIN + 2304 + ln * 8);
            float x[8] = {bf_lo(z.x), bf_hi(z.x), bf_lo(z.y), bf_hi(z.y), bf_lo(z.z), bf_hi(z.z), bf_lo(z.w), bf_hi(z.w)};
            float ss = 0.f;
#pragma unroll
            for (int i = 0; i < 8; ++i) ss += x[i] * x[i];
            ss += __shfl_xor(ss, 1); ss += __shfl_xor(ss, 2); ss += __shfl_xor(ss, 4);
            const float rr = 1.0f / sqrtf(ss * (1.0f / 64.0f) + 1e-6f);
            const bool isk = ln < 16;
#pragma unroll
            for (int i = 0; i < 8; ++i) {
                const float xn = x[i] * rr * gk[i];
                const float o = __shfl_xor(xn, 2);
                const float r = (sb & 2) ? xn * cs[i] + o * sn[i] : xn * cs[i] - o * sn[i];
                x[i] = isk ? (lat ? r : xn) : x[i];
            }
            if (lane < 32) {
                const int kvh = (ln >> 3) & 1;
                bf16_t* dstb = isk ? Kb : Vb;
                size_t off;
                if (!lat) { const int s = row >> 8; off = ((size_t)(s * 2 + kvh) * 256 + tl) * 64 + sb * 8; }
                else { const int bb = (row - TCTX) >> 11; off = (size_t)KV_LAT_OFF + ((size_t)(bb * 2 + kvh) * 2560 + 512 + tl) * 64 + sb * 8; }
                u32x4 w; w.x = cvt_pk(x[0], x[1]); w.y = cvt_pk(x[2], x[3]); w.z = cvt_pk(x[4], x[5]); w.w = cvt_pk(x[6], x[7]);
                *(u32x4*)(dstb + off) = w;
                if (!lat) {
                    const int s = row >> 8;
                    float* o = p.out + (isk ? OUT_CK : OUT_CV) + ((((size_t)s * 2 + l) * 256 + tl) * 2 + kvh) * 64 + sb * 8;
                    *(f32x4*)o = (f32x4){x[0], x[1], x[2], x[3]}; *(f32x4*)(o + 4) = (f32x4){x[4], x[5], x[6], x[7]};
                }
            }
        }
    }
}
__device__ __forceinline__ void prepc_item(const Params& p, int l, int it) {
    const int tid_ = otid(); const int lane = tid_ & 63, wave = tid_ >> 6;
    bf16_t* Kb = (bf16_t*)(p.ws + WS_K); bf16_t* Vb = (bf16_t*)(p.ws + WS_V);
    for (int r = 0; r < 16; ++r) {
        const int bp = it * 128 + wave * 16 + r;
        const int bb = bp >> 9, pos = bp & 511;
        if (lane < 32) {
            const bool isk = lane < 16; const int ln = lane & 15, kvh = ln >> 3, sb = ln & 7;
            const float* src = (isk ? p.in[2] : p.in[3]) + ((((size_t)bb * 2 + l) * 512 + pos) * 2 + kvh) * 64 + sb * 8;
            const f32x4 a = *(const f32x4*)src, b = *(const f32x4*)(src + 4);
            u32x4 w; w.x = cvt_pk(a[0], a[1]); w.y = cvt_pk(a[2], a[3]); w.z = cvt_pk(b[0], b[1]); w.w = cvt_pk(b[2], b[3]);
            *(u32x4*)((isk ? Kb : Vb) + (size_t)KV_LAT_OFF + ((size_t)(bb * 2 + kvh) * 2560 + pos) * 64 + sb * 8) = w;
        }
    }
}

__device__ __forceinline__ void hgrn_item(const Params& p, int l, int L, int rowbase, int bidx, bool lat, int h, int dir, int eg, LAS unsigned char* lds) {
    const int tid = otid();
    LAS float* qs = (LAS float*)lds;
    LAS float* fs = qs + 4096;
    LAS float* ks = fs + 4096;
    LAS float* vs = ks + 4096;
    LAS float* part = vs + 1024;
    const bf16_t* Z = (const bf16_t*)(p.ws + WS_HZ);
    float* OH = (float*)(p.ws + WS_OH) + (size_t)dir * T * 256;
    const int ss = tid >> 4, sj = tid & 15;
    float lbv[4];
#pragma unroll
    for (int i = 0; i < 4; ++i) {
        const int dd = h * 64 + 4 * sj + i;
        lbv[i] = (l == 0) ? 0.f : 1.0f / (1.0f + __expf(p.in[17][dd] - p.in[17][256 + dd]));
    }
    const int cq = h * 64 + 4 * sj, cf = (dir ? 768 : 512) + h * 64 + 4 * sj, cv = 256 + h * 64 + eg * 16 + sj;
    const int el = tid & 15, dg = tid >> 4;
    float S0 = 0.f, S1 = 0.f;
    if (lat) {
        const float* s0 = p.in[4] + ((((size_t)bidx * 2 + l) * 2 + dir) * 4 + h) * 4096;
        S0 = s0[(2 * dg) * 64 + eg * 16 + el]; S1 = s0[(2 * dg + 1) * 64 + eg * 16 + el];
    }
    const int nb = L >> 5;
    u32x2 rq, rf; unsigned short rv;
#define HG_LOAD(bt) do { const int n_ = (bt) * 32 + ss; const int t_ = dir ? (L - 1 - n_) : n_; const bf16_t* zr_ = Z + (size_t)(rowbase + t_) * NIN; \
        rq = *(const u32x2*)(zr_ + cq); rf = *(const u32x2*)(zr_ + cf); rv = zr_[cv]; } while (0)
#define HG_STAGE(buf) do { const float zq_[4] = {bf_lo(rq.x), bf_hi(rq.x), bf_lo(rq.y), bf_hi(rq.y)}; const float zf_[4] = {bf_lo(rf.x), bf_hi(rf.x), bf_lo(rf.y), bf_hi(rf.y)}; \
        f32x4 fq_, ff_, fk_; _Pragma("unroll") for (int i = 0; i < 4; ++i) { const float f_ = lbv[i] + (1.0f - lbv[i]) * sigmoid_f(zf_[i]); fq_[i] = zq_[i]; ff_[i] = fmaxf(f_, 1e-6f); fk_[i] = 1.0f - f_; } \
        *(LAS f32x4*)(qs + (buf) * 2048 + ss * 64 + 4 * sj) = fq_; *(LAS f32x4*)(fs + (buf) * 2048 + ss * 64 + 4 * sj) = ff_; *(LAS f32x4*)(ks + (buf) * 2048 + ss * 64 + 4 * sj) = fk_; \
        vs[(buf) * 512 + ss * 16 + sj] = __uint_as_float((unsigned)rv << 16); } while (0)
    HG_LOAD(0);
    HG_STAGE(0);
    __syncthreads();
    for (int bt = 0; bt < nb; ++bt) {
        const int cur = bt & 1;
        if (bt + 1 < nb) HG_LOAD(bt + 1);
        const LAS float* q_ = qs + cur * 2048 + 2 * dg; const LAS float* f_ = fs + cur * 2048 + 2 * dg; const LAS float* k_ = ks + cur * 2048 + 2 * dg;
        const LAS float* v_ = vs + cur * 512 + el;
#pragma unroll 8
        for (int s = 0; s < 32; ++s) {
            const f32x2 f2 = *(const LAS f32x2*)(f_ + s * 64), k2 = *(const LAS f32x2*)(k_ + s * 64), q2 = *(const LAS f32x2*)(q_ + s * 64);
            const float v = v_[s * 16];
            S0 = f2[0] * S0 + k2[0] * v; S1 = f2[1] * S1 + k2[1] * v;
            part[s * 528 + tid] = q2[0] * S0 + q2[1] * S1;
        }
        __syncthreads();
        {
            float o = 0.f;
#pragma unroll
            for (int g = 0; g < 32; ++g) o += part[ss * 528 + g * 16 + sj];
            const int n = bt * 32 + ss; const int t = dir ? (L - 1 - n) : n;
            OH[(size_t)(rowbase + t) * 256 + h * 64 + eg * 16 + sj] = o;
        }
        if (bt + 1 < nb) HG_STAGE(cur ^ 1);
        __syncthreads();
    }
#undef HG_LOAD
#undef HG_STAGE
    if (!lat) {
        float* sf = p.out + OUT_ST + ((((size_t)bidx * 2 + l) * 2 + dir) * 4 + h) * 4096;
        sf[(2 * dg) * 64 + eg * 16 + el] = S0; sf[(2 * dg + 1) * 64 + eg * 16 + el] = S1;
    }
}

__device__ __forceinline__ void hfin_item(const Params& p, int l, int it) {
    const int tid_ = otid(); const int lane = tid_ & 63, wave = tid_ >> 6;
    const bf16_t* Z = (const bf16_t*)(p.ws + WS_HZ); const float* OH = (const float*)(p.ws + WS_OH); bf16_t* O = (bf16_t*)(p.ws + WS_A);
    const f32x4 g = *(const f32x4*)(p.in[18] + l * 256 + lane * 4);
    for (int r8 = 0; r8 < 8; ++r8) {
        const int row = it * 64 + wave * 8 + r8;
        const f32x4 a = *(const f32x4*)(OH + (size_t)row * 256 + lane * 4) + *(const f32x4*)(OH + (size_t)T * 256 + (size_t)row * 256 + lane * 4);
        float ss = (a[0] * a[0] + a[1] * a[1]) + (a[2] * a[2] + a[3] * a[3]);
        ss += __shfl_xor(ss, 1); ss += __shfl_xor(ss, 2); ss += __shfl_xor(ss, 4); ss += __shfl_xor(ss, 8);
        const float rr = 1.0f / sqrtf(ss * (1.0f / 64.0f) + 1e-6f);
        const u32x2 z = *(const u32x2*)(Z + (size_t)row * NIN + 1024 + lane * 4);
        const float o0 = a[0] * rr * g[0] * silu_f(bf_lo(z.x)), o1 = a[1] * rr * g[1] * silu_f(bf_hi(z.x));
        const float o2 = a[2] * rr * g[2] * silu_f(bf_lo(z.y)), o3 = a[3] * rr * g[3] * silu_f(bf_hi(z.y));
        u32x2 w; w.x = cvt_pk(o0, o1); w.y = cvt_pk(o2, o3);
        *(u32x2*)(O + (size_t)row * D + lane * 4) = w;
    }
}

__device__ __forceinline__ void conv_item(const Params& p, int l, int it, LAS unsigned char* lds) {
    const int tid = otid(), lane = tid & 63, wave = tid >> 6;
    LAS float* ul = (LAS float*)lds;
    LAS float* res = ul + 62 * 256;
    const bf16_t* Z = (const bf16_t*)(p.ws + WS_HZ); bf16_t* O = (bf16_t*)(p.ws + WS_A);
    const int row0 = it * 32;
    int seq0, L;
    if (row0 < TCTX) { seq0 = row0 & ~255; L = 256; } else { seq0 = TCTX + ((row0 - TCTX) & ~2047); L = 2048; }
    for (int i = tid; i < 62 * 32; i += NTHREADS) {
        const int rr = i >> 5, ch = (i & 31) * 8;
        const int prow = row0 - 15 + rr;
        f32x4 u0 = {0.f, 0.f, 0.f, 0.f}, u1 = u0;
        if (prow >= seq0 && prow < seq0 + L) {
            const u32x4 a = *(const u32x4*)(Z + (size_t)prow * NIN + 1280 + ch), b = *(const u32x4*)(Z + (size_t)prow * NIN + 1536 + ch);
            u0[0] = bf_lo(a.x) * sigmoid_f(bf_lo(b.x)); u0[1] = bf_hi(a.x) * sigmoid_f(bf_hi(b.x));
            u0[2] = bf_lo(a.y) * sigmoid_f(bf_lo(b.y)); u0[3] = bf_hi(a.y) * sigmoid_f(bf_hi(b.y));
            u1[0] = bf_lo(a.z) * sigmoid_f(bf_lo(b.z)); u1[1] = bf_hi(a.z) * sigmoid_f(bf_hi(b.z));
            u1[2] = bf_lo(a.w) * sigmoid_f(bf_lo(b.w)); u1[3] = bf_hi(a.w) * sigmoid_f(bf_hi(b.w));
        }
        *(LAS f32x4*)(ul + rr * 256 + ch) = u0; *(LAS f32x4*)(ul + rr * 256 + ch + 4) = u1;
    }
    __syncthreads();
    {
        const int c = tid & 255, half = tid >> 8;
        float w[31];
#pragma unroll
        for (int j = 0; j < 31; ++j) w[j] = p.in[19][((size_t)l * 31 + j) * 256 + c];
        const float bias = p.in[20][l * 256 + c];
        float uu[46];
#pragma unroll
        for (int i = 0; i < 46; ++i) uu[i] = ul[(half * 16 + i) * 256 + c];
#pragma unroll
        for (int pp = 0; pp < 16; ++pp) {
            float acc = bias;
#pragma unroll
            for (int j = 0; j < 31; ++j) acc += w[j] * uu[pp + j];
            res[(half * 16 + pp) * 256 + c] = acc;
        }
    }
    __syncthreads();
    {
        const f32x4 g = *(const f32x4*)(p.in[21] + l * 256 + lane * 4), b = *(const f32x4*)(p.in[22] + l * 256 + lane * 4);
#pragma unroll
        for (int r = 0; r < 4; ++r) {
            const int pp = wave * 4 + r;
            f32x4 x = *(const LAS f32x4*)(res + pp * 256 + lane * 4);
            const float mean = wave_sum((x[0] + x[1]) + (x[2] + x[3])) * (1.0f / 256.0f);
            x = x - mean;
            const float var = wave_sum((x[0] * x[0] + x[1] * x[1]) + (x[2] * x[2] + x[3] * x[3])) * (1.0f / 256.0f);
            const float rstd = 1.0f / sqrtf(var + 1e-5f);
            x = x * rstd * g + b;
            u32x2 w; w.x = cvt_pk(silu_f(x[0]), silu_f(x[1])); w.y = cvt_pk(silu_f(x[2]), silu_f(x[3]));
            *(u32x2*)(O + (size_t)(row0 + pp) * D + 256 + lane * 4) = w;
        }
    }
}

template <int NQ>
__device__ __forceinline__ void attn_item(const bf16_t* Qb, const bf16_t* Kp, const bf16_t* Vp, int Lk, int qrow0, int kvh, bf16_t* O, LAS unsigned char* lds) {
    const int tid = otid(), lane = tid & 63, wave = tid >> 6;
    const int g = wave >> 1, sub = wave & 1, head = kvh * 4 + g;
    const int qr = lane & 15, kq = lane >> 4;
    bf16x8 qf[NQ][2];
#pragma unroll
    for (int qi = 0; qi < NQ; ++qi) {
        const int row = qrow0 + sub * (16 * NQ) + qi * 16 + qr;
#pragma unroll
        for (int ks = 0; ks < 2; ++ks) qf[qi][ks] = *(const bf16x8*)(Qb + (size_t)row * 512 + head * 64 + ks * 32 + kq * 8);
    }
    f32x4 o[NQ][4]; float mrun[NQ], lsum[NQ];
#pragma unroll
    for (int qi = 0; qi < NQ; ++qi) { mrun[qi] = -1e30f; lsum[qi] = 0.f;
#pragma unroll
        for (int dt = 0; dt < 4; ++dt) o[qi][dt] = (f32x4){0.f, 0.f, 0.f, 0.f}; }
    const int skey = tid >> 3, sch = tid & 7;
    const int ntile = Lk >> 6;
    u32x4 rk = *(const u32x4*)(Kp + (size_t)skey * 64 + sch * 8), rv = *(const u32x4*)(Vp + (size_t)skey * 64 + sch * 8);
#define AT_KBUF(b) (lds + (b) * 9216)
#define AT_VBUF(b) (lds + 18432 + (b) * 8704)
#define AT_STAGE(b) do { *(LAS u32x4*)(AT_KBUF(b) + skey * 144 + sch * 16) = rk; LAS unsigned short* vt_ = (LAS unsigned short*)(AT_VBUF(b) + (sch * 8) * 136 + skey * 2); \
        vt_[0 * 68] = (unsigned short)(rv.x & 0xffffu); vt_[1 * 68] = (unsigned short)(rv.x >> 16); vt_[2 * 68] = (unsigned short)(rv.y & 0xffffu); vt_[3 * 68] = (unsigned short)(rv.y >> 16); \
        vt_[4 * 68] = (unsigned short)(rv.z & 0xffffu); vt_[5 * 68] = (unsigned short)(rv.z >> 16); vt_[6 * 68] = (unsigned short)(rv.w & 0xffffu); vt_[7 * 68] = (unsigned short)(rv.w >> 16); } while (0)
    AT_STAGE(0);
    __syncthreads();
    for (int kt = 0; kt < ntile; ++kt) {
        const int cur = kt & 1;
        if (kt + 1 < ntile) { rk = *(const u32x4*)(Kp + (size_t)((kt + 1) * 64 + skey) * 64 + sch * 8); rv = *(const u32x4*)(Vp + (size_t)((kt + 1) * 64 + skey) * 64 + sch * 8); }
        f32x4 s[NQ][4];
        const LAS unsigned char* kb = AT_KBUF(cur);
#pragma unroll
        for (int t4 = 0; t4 < 4; ++t4) {
            const bf16x8 ka0 = *(const LAS bf16x8*)(kb + (t4 * 16 + qr) * 144 + kq * 16);
            const bf16x8 ka1 = *(const LAS bf16x8*)(kb + (t4 * 16 + qr) * 144 + 64 + kq * 16);
#pragma unroll
            for (int qi = 0; qi < NQ; ++qi) {
                f32x4 z = {0.f, 0.f, 0.f, 0.f};
                z = __builtin_amdgcn_mfma_f32_16x16x32_bf16(ka0, qf[qi][0], z, 0, 0, 0);
                s[qi][t4] = __builtin_amdgcn_mfma_f32_16x16x32_bf16(ka1, qf[qi][1], z, 0, 0, 0);
            }
        }
        bf16x8 pb[NQ][2];
#pragma unroll
        for (int qi = 0; qi < NQ; ++qi) {
            float mx = -1e30f;
#pragma unroll
            for (int t4 = 0; t4 < 4; ++t4) mx = fmaxf(mx, fmaxf(fmaxf(s[qi][t4][0], s[qi][t4][1]), fmaxf(s[qi][t4][2], s[qi][t4][3])));
            mx = fmaxf(mx, __shfl_xor(mx, 16)); mx = fmaxf(mx, __shfl_xor(mx, 32));
            const float mnew = fmaxf(mrun[qi], mx);
            const float alpha = __builtin_amdgcn_exp2f(mrun[qi] - mnew);
            mrun[qi] = mnew;
            float psum = 0.f;
#pragma unroll
            for (int t4 = 0; t4 < 4; ++t4)
#pragma unroll
                for (int j = 0; j < 4; ++j) { const float pv = __builtin_amdgcn_exp2f(s[qi][t4][j] - mnew); s[qi][t4][j] = pv; psum += pv; }
            lsum[qi] = lsum[qi] * alpha + psum;
#pragma unroll
            for (int dt = 0; dt < 4; ++dt) o[qi][dt] = o[qi][dt] * alpha;
#pragma unroll
            for (int kp = 0; kp < 2; ++kp) {
                u32x4 w; w.x = cvt_pk_c(s[qi][2 * kp][0], s[qi][2 * kp][1]); w.y = cvt_pk_c(s[qi][2 * kp][2], s[qi][2 * kp][3]);
                w.z = cvt_pk_c(s[qi][2 * kp + 1][0], s[qi][2 * kp + 1][1]); w.w = cvt_pk_c(s[qi][2 * kp + 1][2], s[qi][2 * kp + 1][3]);
                pb[qi][kp] = __builtin_bit_cast(bf16x8, w);
            }
        }
        const LAS unsigned char* vb = AT_VBUF(cur);
#pragma unroll
        for (int dt = 0; dt < 4; ++dt)
#pragma unroll
            for (int kp = 0; kp < 2; ++kp) {
                const u32x2 lo = *(const LAS u32x2*)(vb + (dt * 16 + qr) * 136 + ((2 * kp) * 16 + kq * 4) * 2);
                const u32x2 hi = *(const LAS u32x2*)(vb + (dt * 16 + qr) * 136 + ((2 * kp + 1) * 16 + kq * 4) * 2);
                const u32x4 w = {lo.x, lo.y, hi.x, hi.y};
                const bf16x8 va = __builtin_bit_cast(bf16x8, w);
#pragma unroll
                for (int qi = 0; qi < NQ; ++qi) o[qi][dt] = __builtin_amdgcn_mfma_f32_16x16x32_bf16(va, pb[qi][kp], o[qi][dt], 0, 0, 0);
            }
        if (kt + 1 < ntile) AT_STAGE(cur ^ 1);
        __syncthreads();
    }
#undef AT_STAGE
#undef AT_KBUF
#undef AT_VBUF
#pragma unroll
    for (int qi = 0; qi < NQ; ++qi) {
        float ls = lsum[qi]; ls += __shfl_xor(ls, 16); ls += __shfl_xor(ls, 32);
        const float inv = 1.0f / ls;
        const int row = qrow0 + sub * (16 * NQ) + qi * 16 + qr;
#pragma unroll
        for (int dt = 0; dt < 4; ++dt) {
            const f32x4 v = o[qi][dt] * inv;
            u32x2 w; w.x = cvt_pk_c(v[0], v[1]); w.y = cvt_pk_c(v[2], v[3]);
            *(u32x2*)(O + (size_t)row * D + 512 + head * 64 + dt * 16 + kq * 4) = w;
        }
    }
}

__device__ __forceinline__ void mix_a(const Params& p, int l, unsigned* ctr, LAS unsigned char* lds) {
    LAS int* slot = (LAS int*)(lds + LDS_BYTES - 64);
    constexpr int N_HL = 64, N_HC = 1024, N_CV = 384, N_PR = 192, N_PC = 8, TOT = N_HL + N_HC + N_CV + N_PR + N_PC;
    int qk = 0;
    for (;;) {
        int it = next_item(ctr, slot, qk);
        if (it >= TOT) break;
        if (it < N_HL) { const int eg = it & 3, dir = (it >> 2) & 1, h = (it >> 3) & 3, b = it >> 5; hgrn_item(p, l, 2048, TCTX + b * 2048, b, true, h, dir, eg, lds); continue; }
        it -= N_HL;
        if (it < N_HC) { const int eg = it & 3, dir = (it >> 2) & 1, h = (it >> 3) & 3, s = it >> 5; hgrn_item(p, l, 256, s * 256, s, false, h, dir, eg, lds); continue; }
        it -= N_HC;
        if (it < N_CV) { conv_item(p, l, it, lds); continue; }
        it -= N_CV;
        if (it < N_PR) { prep_item(p, l, it); continue; }
        it -= N_PR;
        prepc_item(p, l, it);
    }
}
__device__ __forceinline__ void mix_b(const Params& p, int l, unsigned* ctr, LAS unsigned char* lds) {
    LAS int* slot = (LAS int*)(lds + LDS_BYTES - 64);
    constexpr int N_AL = 256, N_AC = 256, N_HF = 192, TOT = N_AL + N_AC + N_HF;
    const bf16_t* Qb = (const bf16_t*)(p.ws + WS_Q); const bf16_t* Kb = (const bf16_t*)(p.ws + WS_K); const bf16_t* Vb = (const bf16_t*)(p.ws + WS_V);
    bf16_t* O = (bf16_t*)(p.ws + WS_A);
    int qk = 0;
    for (;;) {
        int it = next_item(ctr, slot, qk);
        if (it >= TOT) break;
        if (it < N_AL) {
            const int qt = it & 63, kvh = (it >> 6) & 1, b = it >> 7;
            const size_t off = (size_t)KV_LAT_OFF + (size_t)(b * 2 + kvh) * 2560 * 64;
            if (EN_MASK & 64) attn_item<1>(Qb, Kb + off, Vb + off, 2560, TCTX + b * 2048 + qt * 32, kvh, O, lds);
            continue;
        }
        it -= N_AL;
        if (it < N_AC) {
            const int qt = it & 3, kvh = (it >> 2) & 1, s = it >> 3;
            const size_t off = (size_t)(s * 2 + kvh) * 256 * 64;
            if (EN_MASK & 128) attn_item<2>(Qb, Kb + off, Vb + off, 256, s * 256 + qt * 64, kvh, O, lds);
            continue;
        }
        it -= N_AC;
        if (EN_MASK & 256) hfin_item(p, l, it);
    }
}

#define XB_TMO      128
#define XB_XCNT(j)  (256  + 64 * (j))
#define XB_XSUB(j)  (1280 + 64 * (j))
#define XB_XGEN(j)  (2304 + 64 * (j))
#define XB_TOP      3328
#define XB_TOPGEN   3392
#define XCD_BAR_WORDS 3456
#define XB_SPIN_CAP (1u << 18)

__device__ __forceinline__ unsigned xb_ld(unsigned* p)              { return __hip_atomic_load(p, __ATOMIC_RELAXED, __HIP_MEMORY_SCOPE_AGENT); }
__device__ __forceinline__ unsigned xb_add(unsigned* p, unsigned v) { return __hip_atomic_fetch_add(p, v, __ATOMIC_RELAXED, __HIP_MEMORY_SCOPE_AGENT); }
__device__ __forceinline__ unsigned xb_xcc_id() { return (unsigned)__builtin_amdgcn_s_getreg((3 << 11) | 20) & 0xFu; }
#define XB_SPIN(cond, bar) do { unsigned _sp = 0; while (cond) { __builtin_amdgcn_s_sleep(1); \
    if ((++_sp & 255u) == 0u) { if (xb_ld(&(bar)[XB_TMO])) break; if (_sp > XB_SPIN_CAP) { atomicAdd(&(bar)[XB_TMO], 1u); break; } } } } while (0)

struct XcdBarrier {
    unsigned* bar; unsigned x;
    volatile LAS unsigned* st;
};

__device__ __forceinline__ XcdBarrier xcd_barrier_post(unsigned* bar, volatile LAS unsigned* st) {
    XcdBarrier b; b.bar = bar; b.x = xb_xcc_id(); b.st = st;
    if (threadIdx.x == 0) (void)xb_add(&bar[XB_XCNT(b.x)], 1u);
    return b;
}
__device__ __forceinline__ void xcd_barrier_complete(unsigned* bar, unsigned x, unsigned& nloc, unsigned& nx) {
    const unsigned G = gridDim.x * gridDim.y * gridDim.z;
    unsigned sum, cnt, mine, sp = 0u;
    for (;;) {
        sum = 0u; cnt = 0u; mine = 0u;
#pragma unroll
        for (unsigned j = 0; j < 16; ++j) { const unsigned c = xb_ld(&bar[XB_XCNT(j)]); sum += c; cnt += (c > 0u) ? 1u : 0u; mine = (j == x) ? c : mine; }
        if (sum == G) break;
        __builtin_amdgcn_s_sleep(1);
        if ((++sp & 255u) == 0u) { if (xb_ld(&bar[XB_TMO])) break; if (sp > XB_SPIN_CAP) { atomicAdd(&bar[XB_TMO], 1u); break; } }
    }
    nloc = mine > 0u ? mine : 1u; nx = cnt > 0u ? cnt : 1u;
}

__device__ __forceinline__ void xcd_barrier(const XcdBarrier& b) {
    asm volatile("s_waitcnt vmcnt(0)" ::: "memory");
    __syncthreads();
    if (threadIdx.x == 0) {
        unsigned* bar = b.bar;
        __builtin_amdgcn_s_waitcnt(0);
        unsigned nloc = b.st[0], nx = b.st[1];
        if (nloc == 0u) { xcd_barrier_complete(bar, b.x, nloc, nx); b.st[0] = nloc; b.st[1] = nx; }
        const unsigned old = xb_add(&bar[XB_XSUB(b.x)], 1u);
        const unsigned gen = old / nloc;
        if (old + 1u == (gen + 1u) * nloc) {
            __builtin_amdgcn_fence(__ATOMIC_RELEASE, "agent");
            asm volatile("s_waitcnt vmcnt(0)" ::: "memory");
            const unsigned og = xb_add(&bar[XB_TOP], 1u);
            const unsigned tg = og / nx;
            if (og + 1u == (tg + 1u) * nx) xb_add(&bar[XB_TOPGEN], 1u);
            else XB_SPIN(xb_ld(&bar[XB_TOPGEN]) == tg, bar);
            __builtin_amdgcn_fence(__ATOMIC_ACQUIRE, "agent");
            xb_add(&bar[XB_XGEN(b.x)], 1u);
            asm volatile("s_waitcnt vmcnt(0)" ::: "memory");
        } else {
            XB_SPIN(xb_ld(&bar[XB_XGEN(b.x)]) == gen, bar);
            __builtin_amdgcn_fence(__ATOMIC_ACQUIRE, "agent");
            asm volatile("s_waitcnt vmcnt(0)" ::: "memory");
        }
    }
    __syncthreads();
}

__global__ void __launch_bounds__(NTHREADS, 2) fwd_megakernel(Params p) {
    extern __shared__ __attribute__((aligned(16))) unsigned char lds_raw[];
    LAS unsigned char* lds = (LAS unsigned char*)lds_raw;
    cg::grid_group grid = cg::this_grid();
#define GSYNC1() xcd_barrier(xbar)
#define GSYNC() do { GSYNC1(); if (REP_MASK & 32) GSYNC1(); } while (0)
    const int G = gridDim.x, c = blockIdx.x;
    unsigned* ctl = (unsigned*)(p.ws + WS_CTL);
    { volatile LAS unsigned* st0 = (volatile LAS unsigned*)(lds + LDS_BYTES - 32); if (threadIdx.x < 2) st0[threadIdx.x] = 0u; }
    __syncthreads();
    grid.sync();
    const XcdBarrier xbar = xcd_barrier_post(ctl + 1024, (volatile LAS unsigned*)(lds + LDS_BYTES - 32));
    float* X = (float*)(p.ws + WS_X);
    const bf16_t* A = (const bf16_t*)(p.ws + WS_A);
    bf16_t* HZ = (bf16_t*)(p.ws + WS_HZ);
    const float* MOD = (const float*)(p.ws + WS_MOD);

    if (EN_MASK & 32) prologue(p, lds);
    if (REP_MASK & 1) { __syncthreads(); prologue(p, lds); }
    GSYNC();
    init_rows(p);
    GSYNC();
#pragma unroll 1
    for (int l = 0; l < 2; ++l) {
        const unsigned char* wl = p.ws + WS_W + (size_t)l * W_LAYER;
        const float* modl = MOD + (size_t)l * 3 * NMOD;
        { pg8::Gemm g{A, (const bf16_t*)(wl + W_1IN), T, 2 * DFF, D}; pg8::StaticOrder S; S.init(T, 2 * DFF, G, c); EpiSwiglu E{HZ};
          if (EN_MASK & 1) pg8::gemm_phase<EpiSwiglu, pg8::StaticOrder, true, true>(lds, g, S, E);
          if (REP_MASK & 2) pg8::gemm_phase<EpiSwiglu, pg8::StaticOrder, true, true>(lds, g, S, E); }
        GSYNC();
        { pg8::Gemm g{HZ, (const bf16_t*)(wl + W_1OUT), T, D, DFF}; pg8::StaticOrder S; S.init(T, D, G, c); EpiResid E{X, modl + 2 * 1024, 0.5f};
          if (EN_MASK & 2) pg8::gemm_phase<EpiResid, pg8::StaticOrder, true, true>(lds, g, S, E); }
        GSYNC();
        ln_rows(p, p.in[9] + (size_t)(l * 3 + 0) * D, p.in[10] + (size_t)(l * 3 + 0) * D, modl, 3, nullptr);
        GSYNC();
        { pg8::Gemm g{A, (const bf16_t*)(wl + W_IN), T, NIN, D}; pg8::StaticOrder S; S.init(T, NIN, G, c); EpiZ E{HZ, NIN};
          if (EN_MASK & 4) pg8::gemm_phase<EpiZ, pg8::StaticOrder, true, true>(lds, g, S, E);
          if (REP_MASK & 4) pg8::gemm_phase<EpiZ, pg8::StaticOrder, true, true>(lds, g, S, E); }
        GSYNC();
        if (EN_MASK & 8) mix_a(p, l, ctl + 64 * (2 * l), lds);
        if (REP_MASK & 8) mix_a(p, l, ctl + 64 * (2 * l), lds);
        GSYNC();
        if (EN_MASK & 16) mix_b(p, l, ctl + 64 * (2 * l + 1), lds);
        if (REP_MASK & 16) mix_b(p, l, ctl + 64 * (2 * l + 1), lds);
        GSYNC();
        { pg8::Gemm g{A, (const bf16_t*)(wl + W_OUT), T, D, D}; pg8::StaticOrder S; S.init(T, D, G, c); EpiResid E{X, modl + 5 * 1024, 1.0f};
          if (EN_MASK & 2) pg8::gemm_phase<EpiResid, pg8::StaticOrder, true, true>(lds, g, S, E); }
        GSYNC();
        ln_rows(p, p.in[9] + (size_t)(l * 3 + 1) * D, p.in[10] + (size_t)(l * 3 + 1) * D, modl, 6, nullptr);
        GSYNC();
        { pg8::Gemm g{A, (const bf16_t*)(wl + W_2IN), T, 2 * DFF, D}; pg8::StaticOrder S; S.init(T, 2 * DFF, G, c); EpiSwiglu E{HZ};
          if (EN_MASK & 1) pg8::gemm_phase<EpiSwiglu, pg8::StaticOrder, true, true>(lds, g, S, E);
          if (REP_MASK & 2) pg8::gemm_phase<EpiSwiglu, pg8::StaticOrder, true, true>(lds, g, S, E); }
        GSYNC();
        { pg8::Gemm g{HZ, (const bf16_t*)(wl + W_2OUT), T, D, DFF}; pg8::StaticOrder S; S.init(T, D, G, c); EpiResid E{X, modl + 8 * 1024, 0.5f};
          if (EN_MASK & 2) pg8::gemm_phase<EpiResid, pg8::StaticOrder, true, true>(lds, g, S, E); }
        GSYNC();
        if (l == 0) {
            ln_rows(p, p.in[9] + (size_t)(l * 3 + 2) * D, p.in[10] + (size_t)(l * 3 + 2) * D, MOD + (size_t)3 * NMOD, 0, nullptr);
            GSYNC();
        } else {
            ln_rows(p, p.in[9] + (size_t)(l * 3 + 2) * D, p.in[10] + (size_t)(l * 3 + 2) * D, MOD, 0, p.out + OUT_Y);
        }
    }
}

extern "C" void kernel_launch(void* const* d_in, const int* in_sizes, int n_in, void* d_out, int out_size, void* d_ws, size_t ws_size, hipStream_t stream) {
    static int grid_blocks = 0;
    if (grid_blocks == 0) {
        if (n_in != 25 || ws_size < WS_END) { fprintf(stderr, "kernel_launch: unexpected n_in %d or ws_size %zu (< %zu)\n", n_in, ws_size, (size_t)WS_END); grid_blocks = -1; return; }
        int dev = 0, cus = 0, per_cu = 0;
        hipGetDevice(&dev);
        hipDeviceGetAttribute(&cus, hipDeviceAttributeMultiprocessorCount, dev);
        if (hipFuncSetAttribute((const void*)fwd_megakernel, hipFuncAttributeMaxDynamicSharedMemorySize, LDS_BYTES) != hipSuccess) { fprintf(stderr, "kernel_launch: hipFuncSetAttribute failed\n"); grid_blocks = -1; return; }
        if (hipOccupancyMaxActiveBlocksPerMultiprocessor(&per_cu, (const void*)fwd_megakernel, NTHREADS, LDS_BYTES) != hipSuccess || per_cu < 1) { fprintf(stderr, "kernel_launch: occupancy query failed (%d)\n", per_cu); per_cu = 1; }
        (void)hipGetLastError();
        grid_blocks = cus * per_cu;
    }
    if (grid_blocks < 0) return;
    hipMemsetAsync((char*)d_ws + WS_CTL, 0, CTL_BYTES, stream);
    Params p{};
    for (int i = 0; i < 25; ++i) p.in[i] = (const float*)d_in[i];
    p.out = (float*)d_out; p.ws = (unsigned char*)d_ws;
    void* args[] = {&p};
    hipError_t e = hipLaunchCooperativeKernel((const void*)fwd_megakernel, dim3(grid_blocks), dim3(NTHREADS), args, LDS_BYTES, stream);
    if (e != hipSuccess) fprintf(stderr, "cooperative launch failed: %s (grid %d)\n", hipGetErrorString(e), grid_blocks);
}
```

```cpp
#include <hip/hip_runtime.h>
#include <hip/hip_cooperative_groups.h>
#include <cstdio>
#include <cstdint>
namespace cg = cooperative_groups;
namespace pg8 {
#define PG8_LAS __attribute__((address_space(3)))
typedef unsigned short bf16_t;
typedef short bf16x8 __attribute__((ext_vector_type(8)));
typedef float f32x4 __attribute__((ext_vector_type(4)));
typedef unsigned u32x4 __attribute__((ext_vector_type(4)));
constexpr int BM = 256, BK = 64, HALF = 128, HTB = HALF * BK * 2  , STAGE_BYTES = 8 * HTB, NXCD = 8, WGM = 8;

__host__ __device__ __forceinline__ int lds_byte(int r, int c) { const int st = (r >> 4) * 2 + (c >> 5), rr = r & 15, cc = c & 31, ob = rr * 64 + cc * 2; return st * 1024 + (ob ^ (((ob >> 9) & 1) << 5)); }
__host__ __device__ __forceinline__ void stage_rc(int b, int& R, int& C) { const int st = b / 1024, sb = b % 1024, swz = sb ^ (((sb >> 9) & 1) << 5); R = (st >> 1) * 16 + swz / 64; C = (st & 1) * 32 + (swz % 64) / 2; }
__host__ __device__ __forceinline__ int perm32(int rho) { const int n = rho >> 4, i = rho & 15; return 8 * (i >> 2) + 4 * n + (i & 3); }

struct Unit { int pm, pn; };
struct Gemm { const bf16_t* A; const bf16_t* Bt; int M, N, K; };

struct StaticOrder {
    int nM, nN, nwg, G, c;
    __host__ __device__ void init(int M, int N, int G_, int c_) { nM = M / BM; nN = N / BM; nwg = nM * nN; G = G_; c = c_; }
    __host__ __device__ bool next(int i, Unit& u) const {
        const long L = (long)i * G + c; if (L >= nwg) return false;
        int wgid = (int)L; { const int q = nwg / NXCD, r = nwg % NXCD, xcd = wgid % NXCD, off = wgid / NXCD; wgid = (xcd < r ? xcd * (q + 1) : r * (q + 1) + (xcd - r) * q) + off; }
        const int nig = WGM * nN, gid = wgid / nig, fm = gid * WGM, gsz = (nM - fm) < WGM ? (nM - fm) : WGM;
        u.pm = fm + ((wgid % nig) % gsz); u.pn = (wgid % nig) / gsz; return true;
    }
    __device__ __forceinline__ void a_ready(const Unit&) const {}
    __device__ __forceinline__ void done(const Unit&) const {}
};
__device__ __forceinline__ unsigned cvt_pk_bf16(float lo, float hi) { unsigned r; asm volatile("v_cvt_pk_bf16_f32 %0, %1, %2" : "=v"(r) : "v"(lo), "v"(hi)); return r; }
template <class Epi, class Sched, bool ALIGN_EPI = false, bool SP2 = false>
__device__ __forceinline__ void gemm_phase(PG8_LAS unsigned char* lds, const Gemm g, const Sched& S, const Epi& E) {
    int tid_o = threadIdx.x; asm volatile("" : "+v"(tid_o)); const int tid = tid_o, wid = __builtin_amdgcn_readfirstlane(tid >> 6), lane = tid & 63, wr = wid >> 2, wc = wid & 3, fr = lane & 15, fq = lane >> 4;
    const int K = g.K, nt = K / BK;
    unsigned voffA[2], voffB[2];
#pragma unroll
    for (int i = 0; i < 2; ++i) { int R, C; stage_rc(tid * 16 + i * 8192, R, C); const int Rb = Epi::PERM ? ((R & ~31) + perm32(R & 31)) : R;
        voffA[i] = (unsigned)(R * K + C) * 2u; voffB[i] = (unsigned)(Rb * K + C) * 2u; }
    const size_t kstep = (size_t)(BK * 2);
    const size_t hstep = (size_t)HALF * K * 2;
    const size_t tstep = 2 * hstep;
    const unsigned ldsw = (unsigned)wid * 1024u;
    const int aoff = lds_byte(wr * 64 + fr, fq * 8), boff = lds_byte(wc * 32 + fr, fq * 8);
#define PG8_SA(b, h) (((b) * 2 + (h)) * HTB)
#define PG8_SB(b, h) ((4 + (b) * 2 + (h)) * HTB)
#define PG8_STAGE(bufoff, gbase, voff) do { _Pragma("unroll") for (int _i = 0; _i < 2; ++_i) \
        __builtin_amdgcn_global_load_lds((const unsigned*)((const char*)(gbase) + (voff)[_i]), (PG8_LAS unsigned*)(lds + (bufoff) + ldsw + _i * 8192), 16, 0, 0); } while (0)
#define PG8_LDA(dst, b, h) do { _Pragma("unroll") for (int m = 0; m < 4; ++m) _Pragma("unroll") for (int k = 0; k < 2; ++k) dst[m][k] = *(const PG8_LAS bf16x8*)(lds + PG8_SA(b, h) + aoff + m * 2048 + k * 1024); } while (0)
#define PG8_LDB(dst, b, h) do { _Pragma("unroll") for (int n = 0; n < 2; ++n) _Pragma("unroll") for (int k = 0; k < 2; ++k) dst[n][k] = *(const PG8_LAS bf16x8*)(lds + PG8_SB(b, h) + boff + n * 2048 + k * 1024); } while (0)
#define PG8_MMA(ai, bj, At, Bt) do { __builtin_amdgcn_s_setprio(1); _Pragma("unroll") for (int m = 0; m < 4; ++m) _Pragma("unroll") for (int n = 0; n < 2; ++n) _Pragma("unroll") for (int k = 0; k < 2; ++k) \
        acc[ai][bj][m][n] = __builtin_amdgcn_mfma_f32_16x16x32_bf16(Bt[n][k], At[m][k], acc[ai][bj][m][n], 0, 0, 0); __builtin_amdgcn_s_setprio(0); } while (0)
#define PG8_WAIT_V(n) asm volatile("s_waitcnt vmcnt(" #n ")" ::: "memory")
#define PG8_WAIT_L(n) asm volatile("s_waitcnt lgkmcnt(" #n ")" ::: "memory")
#define PG8_BAR __builtin_amdgcn_s_barrier()
#define PG8_SCHED __builtin_amdgcn_sched_barrier(0)
    Unit cur, nxt; int ui = 0;
    if (!S.next(0, cur)) return;
    f32x4 acc[2][2][4][2];
#pragma unroll
    for (int a = 0; a < 2; ++a)
#pragma unroll
        for (int b = 0; b < 2; ++b)
#pragma unroll
            for (int m = 0; m < 4; ++m)
#pragma unroll
                for (int n = 0; n < 2; ++n) acc[a][b][m][n] = (f32x4){0.f, 0.f, 0.f, 0.f};
    bf16x8 At[4][2], B0[2][2], B1[2][2];
    const char* cA = (const char*)g.A + (size_t)cur.pm * tstep; const char* cB = (const char*)g.Bt + (size_t)cur.pn * tstep;
    S.a_ready(cur);
    if constexpr (SP2) {
        PG8_STAGE(PG8_SB(0, 0), cB, voffB); PG8_STAGE(PG8_SB(0, 1), cB + hstep, voffB); PG8_STAGE(PG8_SA(0, 0), cA, voffA); PG8_STAGE(PG8_SA(0, 1), cA + hstep, voffA);
        if (wr == 1) PG8_BAR;
        PG8_WAIT_V(2); PG8_BAR;
        PG8_STAGE(PG8_SB(1, 0), cB + kstep, voffB); PG8_STAGE(PG8_SA(1, 0), cA + kstep, voffA); PG8_STAGE(PG8_SB(1, 1), cB + hstep + kstep, voffB);
        PG8_WAIT_V(6); PG8_BAR;
    } else {
        PG8_STAGE(PG8_SB(0, 0), cB, voffB); PG8_STAGE(PG8_SA(0, 0), cA, voffA); PG8_STAGE(PG8_SB(0, 1), cB + hstep, voffB); PG8_STAGE(PG8_SA(0, 1), cA + hstep, voffA);
        if (wr == 1) PG8_BAR;
        PG8_WAIT_V(4); PG8_BAR;
        PG8_STAGE(PG8_SB(1, 0), cB + kstep, voffB); PG8_STAGE(PG8_SA(1, 0), cA + kstep, voffA); PG8_STAGE(PG8_SB(1, 1), cB + hstep + kstep, voffB);
        PG8_WAIT_V(6); PG8_BAR;
    }
    for (;;) {
        const bool has_next = S.next(ui + 1, nxt);
        const char* nA = has_next ? (const char*)g.A + (size_t)nxt.pm * tstep : cA; const char* nB = has_next ? (const char*)g.Bt + (size_t)nxt.pn * tstep : cB;
        for (int t = 0; t < nt; t += 2) {
            const bool last = (t == nt - 2);
            const char* a1 = cA + (size_t)(t + 1) * kstep;
            const char* a2 = last ? nA : cA + (size_t)(t + 2) * kstep; const char* b2 = last ? nB : cB + (size_t)(t + 2) * kstep;
            const char* a3 = a2 + kstep; const char* b3 = b2 + kstep;
            if (last && has_next) S.a_ready(nxt);
            if constexpr (SP2) {
            PG8_LDB(B0, 0, 0); PG8_LDB(B1, 0, 1); PG8_SCHED; PG8_LDA(At, 0, 0); PG8_STAGE(PG8_SA(1, 1), a1 + hstep, voffA);
            PG8_WAIT_V(8); PG8_WAIT_L(0); PG8_BAR; PG8_MMA(0, 0, At, B0); PG8_MMA(0, 1, At, B1); PG8_BAR; PG8_SCHED;
            PG8_LDA(At, 0, 1); PG8_STAGE(PG8_SB(0, 0), b2, voffB); PG8_STAGE(PG8_SB(0, 1), b2 + hstep, voffB); PG8_STAGE(PG8_SA(0, 0), a2, voffA);
            PG8_WAIT_V(8); PG8_WAIT_L(0); PG8_BAR; PG8_MMA(1, 0, At, B0); PG8_MMA(1, 1, At, B1); PG8_BAR; PG8_SCHED;
            PG8_LDB(B0, 1, 0); PG8_LDB(B1, 1, 1); PG8_SCHED; PG8_LDA(At, 1, 0); PG8_STAGE(PG8_SA(0, 1), a2 + hstep, voffA);
            PG8_WAIT_V(8); PG8_WAIT_L(0); PG8_BAR; PG8_MMA(0, 0, At, B0); PG8_MMA(0, 1, At, B1); PG8_BAR; PG8_SCHED;
            PG8_LDA(At, 1, 1); PG8_STAGE(PG8_SB(1, 0), b3, voffB); PG8_STAGE(PG8_SB(1, 1), b3 + hstep, voffB); PG8_STAGE(PG8_SA(1, 0), a3, voffA);
            PG8_WAIT_V(8); PG8_WAIT_L(0); PG8_BAR; PG8_MMA(1, 0, At, B0); PG8_MMA(1, 1, At, B1); PG8_BAR; PG8_SCHED;
            } else {
            PG8_LDB(B0, 0, 0); PG8_SCHED; PG8_LDA(At, 0, 0); PG8_STAGE(PG8_SA(1, 1), a1 + hstep, voffA);
            PG8_WAIT_L(8); PG8_BAR; PG8_WAIT_L(0); PG8_MMA(0, 0, At, B0); PG8_BAR; PG8_SCHED;
            PG8_LDB(B1, 0, 1); PG8_STAGE(PG8_SB(0, 0), b2, voffB);
            PG8_BAR; PG8_WAIT_L(0); PG8_MMA(0, 1, At, B1); PG8_BAR;
            PG8_LDA(At, 0, 1); PG8_STAGE(PG8_SA(0, 0), a2, voffA);
            PG8_BAR; PG8_WAIT_L(0); PG8_MMA(1, 0, At, B0); PG8_BAR; PG8_SCHED;
            PG8_STAGE(PG8_SB(0, 1), b2 + hstep, voffB);
            PG8_WAIT_V(6); PG8_BAR; PG8_MMA(1, 1, At, B1); PG8_BAR;
            PG8_LDB(B0, 1, 0); PG8_SCHED; PG8_LDA(At, 1, 0); PG8_STAGE(PG8_SA(0, 1), a2 + hstep, voffA);
            PG8_WAIT_L(8); PG8_BAR; PG8_WAIT_L(0); PG8_MMA(0, 0, At, B0); PG8_BAR; PG8_SCHED;
            PG8_LDB(B1, 1, 1); PG8_STAGE(PG8_SB(1, 0), b3, voffB);
            PG8_BAR; PG8_WAIT_L(0); PG8_MMA(0, 1, At, B1); PG8_BAR;
            PG8_LDA(At, 1, 1); PG8_STAGE(PG8_SA(1, 0), a3, voffA);
            PG8_BAR; PG8_WAIT_L(0); PG8_MMA(1, 0, At, B0); PG8_BAR; PG8_SCHED;
            PG8_STAGE(PG8_SB(1, 1), b3 + hstep, voffB);
            PG8_WAIT_V(6); PG8_BAR; PG8_MMA(1, 1, At, B1); PG8_BAR;
            }
        }
        if constexpr (ALIGN_EPI) { if (wr == 0) PG8_BAR; }
        if constexpr (!Epi::AFTER_DRAIN) { E(acc, cur, wr, wc, fr, fq); S.done(cur); }
        if (!has_next) break;
#pragma unroll
        for (int a = 0; a < 2; ++a)
#pragma unroll
            for (int b = 0; b < 2; ++b)
#pragma unroll
                for (int m = 0; m < 4; ++m)
#pragma unroll
                    for (int n = 0; n < 2; ++n) acc[a][b][m][n] = (f32x4){0.f, 0.f, 0.f, 0.f};
        cur = nxt; cA = nA; cB = nB; ++ui;
        if constexpr (ALIGN_EPI) { if (wr == 1) PG8_BAR; }
    }
    PG8_WAIT_V(0);
    if constexpr (!ALIGN_EPI) { if (wr == 0) PG8_BAR; }
    PG8_BAR;
    if constexpr (Epi::AFTER_DRAIN) { E.fused(acc, cur, wr, wc, fr, fq, lds, wid, lane); S.done(cur); }
#undef PG8_SA
#undef PG8_SB
#undef PG8_STAGE
#undef PG8_LDA
#undef PG8_LDB
#undef PG8_MMA
#undef PG8_WAIT_V
#undef PG8_WAIT_L
#undef PG8_BAR
#undef PG8_SCHED
}
}

#define LAS __attribute__((address_space(3)))
typedef unsigned short bf16_t;
typedef short bf16x8 __attribute__((ext_vector_type(8)));
typedef float f32x4 __attribute__((ext_vector_type(4)));
typedef float f32x2 __attribute__((ext_vector_type(2)));
typedef unsigned u32x4 __attribute__((ext_vector_type(4)));
typedef unsigned u32x2 __attribute__((ext_vector_type(2)));

constexpr int D = 1024, DFF = 2816, NIN = 2560, T = 12288, TCTX = 8192;
constexpr int NMOD = 9216;
constexpr float ALPHA = 1.41421356237309515f;
constexpr float QSCALE = 0.125f * 1.44269504088896341f;
constexpr int NTHREADS = 512, NWAVES = 8;
constexpr int LDS_BYTES = 147456;
#ifndef EN_MASK
#define EN_MASK 0xFFFF
#endif
#ifndef REP_MASK
#define REP_MASK 0
#endif

constexpr size_t MiB = 1u << 20;
constexpr size_t WS_CTL = 0, CTL_BYTES = 65536;
constexpr size_t WS_MOD = 65536;
constexpr size_t WS_ROPE = 524288;
constexpr size_t WS_W = 2 * MiB, W_LAYER = 40 * MiB;
constexpr size_t W_1IN = 0, W_1OUT = 11 * MiB, W_2IN = 16 * MiB + MiB / 2, W_2OUT = 27 * MiB + MiB / 2, W_IN = 33 * MiB, W_OUT = 38 * MiB;
constexpr size_t WS_X = 82 * MiB;
constexpr size_t WS_A = 130 * MiB;
constexpr size_t WS_HZ = 154 * MiB;
constexpr size_t WS_Q = 220 * MiB;
constexpr size_t WS_K = 232 * MiB, WS_V = 236 * MiB;
constexpr size_t WS_OH = 240 * MiB;
constexpr size_t WS_END = 264 * MiB;
constexpr int KV_LAT_OFF = 32 * 2 * 256 * 64;
constexpr size_t OUT_Y = 0, OUT_CK = (size_t)T * D, OUT_CV = OUT_CK + 2097152, OUT_ST = OUT_CV + 2097152;

struct Params { const float* in[25]; float* out; unsigned char* ws; };

__device__ __forceinline__ unsigned cvt_pk(float lo, float hi) { unsigned r; asm("v_cvt_pk_bf16_f32 %0, %1, %2" : "=v"(r) : "v"(lo), "v"(hi)); return r; }
typedef __bf16 bf16x2_t __attribute__((ext_vector_type(2)));
__device__ __forceinline__ unsigned cvt_pk_b(float lo, float hi) { f32x2 v = {lo, hi}; bf16x2_t b = __builtin_convertvector(v, bf16x2_t); return __builtin_bit_cast(unsigned, b); }
__device__ __forceinline__ unsigned cvt_pk_c(float lo, float hi) { unsigned r; asm volatile("v_cvt_pk_bf16_f32 %0, %1, %2\n\ts_nop 1" : "=v"(r) : "v"(lo), "v"(hi)); return r; }
__device__ __forceinline__ float bf_lo(unsigned u) { return __uint_as_float(u << 16); }
__device__ __forceinline__ float bf_hi(unsigned u) { return __uint_as_float(u & 0xffff0000u); }
__device__ __forceinline__ float silu_f(float x) { return x / (1.0f + __expf(-x)); }
__device__ __forceinline__ float sigmoid_f(float x) { return 1.0f / (1.0f + __expf(-x)); }
__device__ __forceinline__ float wave_sum(float v) {
#pragma unroll
    for (int o = 1; o < 64; o <<= 1) v += __shfl_xor(v, o);
    return v;
}
__device__ __forceinline__ int otid() { int t = threadIdx.x; asm volatile("" : "+v"(t)); return t; }
__device__ __forceinline__ int cond_of_row(int row) { return row < TCTX ? 0 : 1 + ((row - TCTX) >> 11); }

struct EpiSwiglu {
    static constexpr bool PERM = true, AFTER_DRAIN = false;
    bf16_t* H;
    __device__ __forceinline__ void operator()(const pg8::f32x4 (&acc)[2][2][4][2], const pg8::Unit& u, int wr, int wc, int fr, int fq) const {
        const int row0 = u.pm * 256 + wr * 64 + fr, col0 = u.pn * 128 + wc * 32 + 8 * fq;
#pragma unroll
        for (int ai = 0; ai < 2; ++ai)
#pragma unroll
            for (int m = 0; m < 4; ++m) {
                bf16_t* rowp = H + (size_t)(row0 + ai * 128 + m * 16) * DFF + col0;
                float h[8];
#pragma unroll
                for (int n = 0; n < 2; ++n)
#pragma unroll
                    for (int i = 0; i < 4; ++i) { const float g = acc[ai][0][m][n][i], up = acc[ai][1][m][n][i]; h[n * 4 + i] = silu_f(g) * up; }
                u32x4 w; w.x = cvt_pk(h[0], h[1]); w.y = cvt_pk(h[2], h[3]); w.z = cvt_pk(h[4], h[5]); w.w = cvt_pk(h[6], h[7]);
                *(u32x4*)rowp = w;
            }
    }
};
struct EpiZ {
    static constexpr bool PERM = true, AFTER_DRAIN = false;
    bf16_t* O; int ldc;
    __device__ __forceinline__ void operator()(const pg8::f32x4 (&acc)[2][2][4][2], const pg8::Unit& u, int wr, int wc, int fr, int fq) const {
        const int row0 = u.pm * 256 + wr * 64 + fr, col0 = u.pn * 256 + wc * 32 + 8 * fq;
#pragma unroll
        for (int ai = 0; ai < 2; ++ai)
#pragma unroll
            for (int m = 0; m < 4; ++m) {
                bf16_t* rowp = O + (size_t)(row0 + ai * 128 + m * 16) * ldc + col0;
#pragma unroll
                for (int bj = 0; bj < 2; ++bj) {
                    const pg8::f32x4 v0 = acc[ai][bj][m][0], v1 = acc[ai][bj][m][1];
                    u32x4 w; w.x = cvt_pk(v0[0], v0[1]); w.y = cvt_pk(v0[2], v0[3]); w.z = cvt_pk(v1[0], v1[1]); w.w = cvt_pk(v1[2], v1[3]);
                    *(u32x4*)(rowp + bj * 128) = w;
                }
            }
    }
};
struct EpiResid {
    static constexpr bool PERM = false, AFTER_DRAIN = false;
    float* X; const float* gate; float s;
    __device__ __forceinline__ void operator()(const pg8::f32x4 (&acc)[2][2][4][2], const pg8::Unit& u, int wr, int wc, int fr, int fq) const {
        const int cond = u.pm < 32 ? 0 : 1 + ((u.pm - 32) >> 3);
        const float* gv = gate + cond * NMOD;
        const int row0 = u.pm * 256 + wr * 64 + fr, col0 = u.pn * 256 + wc * 32 + 4 * fq;
#pragma unroll
        for (int bj = 0; bj < 2; ++bj)
#pragma unroll
            for (int n = 0; n < 2; ++n) {
                const int c = col0 + bj * 128 + n * 16;
                const f32x4 g = *(const f32x4*)(gv + c) * s;
#pragma unroll
                for (int ai = 0; ai < 2; ++ai)
#pragma unroll
                    for (int m = 0; m < 4; ++m) {
                        f32x4* px = (f32x4*)(X + (size_t)(row0 + ai * 128 + m * 16) * D + c);
                        const f32x4 xv = *px;
                        *px = xv * ALPHA + g * acc[ai][bj][m][n];
                    }
            }
    }
};

__device__ __forceinline__ void transpose_item(const float* W, int K, int N, bf16_t* WT, int k0, int n0, int dst_row0, LAS float* scr, int lane) {
#pragma unroll 8
    for (int i = 0; i < 32; ++i) { const int kk = 2 * i + (lane >> 5); scr[kk * 33 + (lane & 31)] = W[(size_t)(k0 + kk) * N + n0 + (lane & 31)]; }
    asm volatile("s_waitcnt lgkmcnt(0)" ::: "memory");
    const int c = lane & 7;
#pragma unroll
    for (int j = 0; j < 4; ++j) {
        const int n = (lane >> 3) + 8 * j; const LAS float* s = scr + (8 * c) * 33 + n;
        u32x4 o; o.x = cvt_pk(s[0 * 33], s[1 * 33]); o.y = cvt_pk(s[2 * 33], s[3 * 33]); o.z = cvt_pk(s[4 * 33], s[5 * 33]); o.w = cvt_pk(s[6 * 33], s[7 * 33]);
        *(u32x4*)(WT + (size_t)(dst_row0 + n) * K + k0 + 8 * c) = o;
    }
    asm volatile("s_waitcnt lgkmcnt(0)" ::: "memory");
}
__device__ __forceinline__ int swiglu_row(int n) { return n < DFF ? (n >> 7) * 256 + (n & 127) : ((n - DFF) >> 7) * 256 + 128 + ((n - DFF) & 127); }

__device__ __forceinline__ void mod_item(const Params& p, int it, LAS unsigned char* lds) {
    const int tid = otid();
    LAS float* sl = (LAS float*)lds;
    LAS float* red = sl + 3072;
    const int l = it / 72, cg0 = (it % 72) * 128;
    for (int i = tid; i < 3072; i += NTHREADS) { const int c = i >> 10, k = i & 1023; const float v = c == 0 ? p.in[6][k] : p.in[5][(c - 1) * 1024 + k]; sl[i] = silu_f(v); }
    __syncthreads();
    const int cq = tid & 31, ks = tid >> 5;
    const float* w = p.in[7] + ((size_t)l * 1024 + ks * 64) * NMOD + cg0 + cq * 4;
    f32x4 a0 = {0.f, 0.f, 0.f, 0.f}, a1 = a0, a2 = a0;
#pragma unroll 8
    for (int k = 0; k < 64; ++k) {
        const f32x4 wv = *(const f32x4*)(w + (size_t)k * NMOD); const int kk = ks * 64 + k;
        a0 += wv * sl[kk]; a1 += wv * sl[1024 + kk]; a2 += wv * sl[2048 + kk];
    }
    *(LAS f32x4*)(red + (ks * 3 + 0) * 128 + cq * 4) = a0;
    *(LAS f32x4*)(red + (ks * 3 + 1) * 128 + cq * 4) = a1;
    *(LAS f32x4*)(red + (ks * 3 + 2) * 128 + cq * 4) = a2;
    __syncthreads();
    if (tid < 384) {
        const int c = tid >> 7, col = tid & 127; float s = 0.f;
#pragma unroll
        for (int k = 0; k < 16; ++k) s += red[(k * 3 + c) * 128 + col];
        ((float*)(p.ws + WS_MOD))[(size_t)(l * 3 + c) * NMOD + cg0 + col] = s + p.in[8][(size_t)l * NMOD + cg0 + col];
    }
    __syncthreads();
}

__device__ __forceinline__ void prologue(const Params& p, LAS unsigned char* lds) {
    const int tid = otid(), lane = tid & 63, wave = tid >> 6;
    const int G = gridDim.x;
    for (int it = blockIdx.x; it < 144; it += G) mod_item(p, it, lds);
    if (blockIdx.x == G - 1) {
        float* rc = (float*)(p.ws + WS_ROPE);
        for (int i = tid; i < 1024; i += NTHREADS) {
            const int pos = i >> 4, pp = i & 15;
            const float inv = exp2f(-(float)pp * (13.287712379549449f / 16.0f));
            const float ang = (float)pos * inv;
            rc[i] = cosf(ang); rc[1024 + i] = sinf(ang);
        }
    }
    __syncthreads();
    LAS float* scr = (LAS float*)(lds + wave * 16384);
    const int gw = blockIdx.x * NWAVES + wave, NGW = G * NWAVES;
    for (int it = gw; it < 20480; it += NGW) {
        const int l = it / 10240; int r = it % 10240;
        bf16_t* wl = (bf16_t*)(p.ws + WS_W + (size_t)l * W_LAYER);
        if (r < 5632) {
            const int which = r / 2816; r %= 2816;
            const int kb = r / 176, nb = r % 176;
            const float* W = p.in[which ? 13 : 11] + (size_t)l * 1024 * 5632;
            transpose_item(W, 1024, 5632, (bf16_t*)((unsigned char*)wl + (which ? W_2IN : W_1IN)), kb * 64, nb * 32, swiglu_row(nb * 32), scr, lane);
        } else if (r < 5632 + 2816) {
            r -= 5632; const int which = r / 1408; r %= 1408;
            const int kb = r / 32, nb = r % 32;
            const float* W = p.in[which ? 14 : 12] + (size_t)l * 2816 * 1024;
            transpose_item(W, 2816, 1024, (bf16_t*)((unsigned char*)wl + (which ? W_2OUT : W_1OUT)), kb * 64, nb * 32, nb * 32, scr, lane);
        } else if (r < 5632 + 2816 + 1280) {
            r -= 5632 + 2816; const int kb = r / 80, nb = r % 80;
            transpose_item(p.in[15] + (size_t)l * 1024 * 2560, 1024, 2560, (bf16_t*)((unsigned char*)wl + W_IN), kb * 64, nb * 32, nb * 32, scr, lane);
        } else {
            r -= 5632 + 2816 + 1280; const int kb = r / 32, nb = r % 32;
            transpose_item(p.in[16] + (size_t)l * 1024 * 1024, 1024, 1024, (bf16_t*)((unsigned char*)wl + W_OUT), kb * 64, nb * 32, nb * 32, scr, lane);
        }
    }
}

__device__ __forceinline__ void store_mod_row(bf16_t* arow, const f32x4 (&x)[4], const float* sh, const float* sc, int lane) {
#pragma unroll
    for (int j = 0; j < 4; ++j) {
        const int c = 4 * lane + 256 * j;
        const f32x4 s = *(const f32x4*)(sh + c), k = *(const f32x4*)(sc + c);
        const f32x4 a = x[j] * (k + 1.0f) + s;
        u32x2 w; w.x = cvt_pk(a[0], a[1]); w.y = cvt_pk(a[2], a[3]);
        *(u32x2*)(arow + c) = w;
    }
}
__device__ __forceinline__ void init_rows(const Params& p) {
    const int tid_ = otid(); const int lane = tid_ & 63, wave = tid_ >> 6;
    const int gw = blockIdx.x * NWAVES + wave, NGW = gridDim.x * NWAVES;
    float* X = (float*)(p.ws + WS_X); bf16_t* A = (bf16_t*)(p.ws + WS_A); const float* MOD = (const float*)(p.ws + WS_MOD);
    for (int row = gw; row < T; row += NGW) {
        const float* src = row < TCTX ? p.in[0] + (size_t)row * D : p.in[1] + (size_t)(row - TCTX) * D;
        const int cond = cond_of_row(row);
        f32x4 v[4];
#pragma unroll
        for (int j = 0; j < 4; ++j) { v[j] = *(const f32x4*)(src + 4 * lane + 256 * j); *(f32x4*)(X + (size_t)row * D + 4 * lane + 256 * j) = v[j]; }
        store_mod_row(A + (size_t)row * D, v, MOD + cond * NMOD + 0 * 1024, MOD + cond * NMOD + 1 * 1024, lane);
    }
}
__device__ __forceinline__ void ln_rows(const Params& p, const float* g, const float* b, const float* modn, int shi, float* final_out) {
    const int tid_ = otid(); const int lane = tid_ & 63, wave = tid_ >> 6;
    const int gw = blockIdx.x * NWAVES + wave, NGW = gridDim.x * NWAVES;
    float* X = (float*)(p.ws + WS_X); bf16_t* A = (bf16_t*)(p.ws + WS_A);
    for (int row = gw; row < T; row += NGW) {
        f32x4 v[4]; float s = 0.f;
#pragma unroll
        for (int j = 0; j < 4; ++j) { v[j] = *(const f32x4*)(X + (size_t)row * D + 4 * lane + 256 * j); s += (v[j][0] + v[j][1]) + (v[j][2] + v[j][3]); }
        const float mean = wave_sum(s) * (1.0f / D); float q = 0.f;
#pragma unroll
        for (int j = 0; j < 4; ++j) { v[j] = v[j] - mean; q += (v[j][0] * v[j][0] + v[j][1] * v[j][1]) + (v[j][2] * v[j][2] + v[j][3] * v[j][3]); }
        const float rstd = 1.0f / sqrtf(wave_sum(q) * (1.0f / D) + 1e-5f);
        float* dst = final_out ? final_out + (size_t)row * D : X + (size_t)row * D;
#pragma unroll
        for (int j = 0; j < 4; ++j) {
            const int c = 4 * lane + 256 * j;
            v[j] = v[j] * rstd * *(const f32x4*)(g + c) + *(const f32x4*)(b + c);
            *(f32x4*)(dst + c) = v[j];
        }
        if (!final_out) { const int cond = cond_of_row(row); store_mod_row(A + (size_t)row * D, v, modn + cond * NMOD + shi * 1024, modn + cond * NMOD + (shi + 1) * 1024, lane); }
    }
}

#ifndef STATIC_Q
#define STATIC_Q 1
#endif
__device__ __forceinline__ int next_item(unsigned* ctr, LAS int* slot, int& k) {
    __syncthreads();
#if STATIC_Q
    const int r = blockIdx.x + k * gridDim.x; ++k; return r;
#else
    if (threadIdx.x == 0) *slot = (int)atomicAdd(ctr, 1u);
    __syncthreads();
    return *slot;
#endif
}

__device__ __forceinline__ void prep_item(const Params& p, int l, int it) {
    const int tid_ = otid(); const int lane = tid_ & 63, wave = tid_ >> 6;
    const bf16_t* Z = (const bf16_t*)(p.ws + WS_HZ);
    bf16_t* Qb = (bf16_t*)(p.ws + WS_Q); bf16_t* Kb = (bf16_t*)(p.ws + WS_K); bf16_t* Vb = (bf16_t*)(p.ws + WS_V);
    const float* rc = (const float*)(p.ws + WS_ROPE);
    const int sb = lane & 7;
    float gq[8], gk[8];
#pragma unroll
    for (int i = 0; i < 8; ++i) { gq[i] = p.in[23][l * 64 + sb * 8 + i]; gk[i] = p.in[24][l * 64 + sb * 8 + i]; }
    for (int r8 = 0; r8 < 8; ++r8) {
        const int row = it * 64 + wave * 8 + r8;
        const bool lat = row >= TCTX;
        const int tl = lat ? ((row - TCTX) & 2047) : (row & 255);
        const int pos = (sb < 4) ? (tl >> 6) : (tl & 63);
        float cs[8], sn[8];
#pragma unroll
        for (int i = 0; i < 8; ++i) { cs[i] = rc[pos * 16 + (sb & 1) * 8 + i]; sn[i] = rc[1024 + pos * 16 + (sb & 1) * 8 + i]; }
        {
            const u32x4 z = *(const u32x4*)(Z + (size_t)row * NIN + 1792 + lane * 8);
            float x[8] = {bf_lo(z.x), bf_hi(z.x), bf_lo(z.y), bf_hi(z.y), bf_lo(z.z), bf_hi(z.z), bf_lo(z.w), bf_hi(z.w)};
            float ss = 0.f;
#pragma unroll
            for (int i = 0; i < 8; ++i) ss += x[i] * x[i];
            ss += __shfl_xor(ss, 1); ss += __shfl_xor(ss, 2); ss += __shfl_xor(ss, 4);
            const float rr = 1.0f / sqrtf(ss * (1.0f / 64.0f) + 1e-6f);
#pragma unroll
            for (int i = 0; i < 8; ++i) x[i] = x[i] * rr * gq[i];
#pragma unroll
            for (int i = 0; i < 8; ++i) {
                const float o = __shfl_xor(x[i], 2);
                const float r = (sb & 2) ? x[i] * cs[i] + o * sn[i] : x[i] * cs[i] - o * sn[i];
                x[i] = (lat ? r : x[i]) * QSCALE;
            }
            u32x4 w; w.x = cvt_pk(x[0], x[1]); w.y = cvt_pk(x[2], x[3]); w.z = cvt_pk(x[4], x[5]); w.w = cvt_pk(x[6], x[7]);
            *(u32x4*)(Qb + (size_t)row * 512 + lane * 8) = w;
        }
        {
            const int ln = lane & 31;
            const u32x4 z = *(const u32x4*)(Z + (size_t)row * NIN + 2304 + ln * 8);
            float x[8] = {bf_lo(z.x), bf_hi(z.x), bf_lo(z.y), bf_hi(z.y), bf_lo(z.z), bf_hi(z.z), bf_lo(z.w), bf_hi(z.w)};
            float ss = 0.f;
#pragma unroll
            for (int i = 0; i < 8; ++i) ss += x[i] * x[i];
            ss += __shfl_xor(ss, 1); ss += __shfl_xor(ss, 2); ss += __shfl_xor(ss, 4);
            const float rr = 1.0f / sqrtf(ss * (1.0f / 64.0f) + 1e-6f);
            const bool isk = ln < 16;
#pragma unroll
            for (int i = 0; i < 8; ++i) {
                const float xn = x[i] * rr * gk[i];
                const float o = __shfl_xor(xn, 2);
                const float r = (sb & 2) ? xn * cs[i] + o * sn[i] : xn * cs[i] - o * sn[i];
                x[i] = isk ? (lat ? r : xn) : x[i];
            }
            if (lane < 32) {
                const int kvh = (ln >> 3) & 1;
                bf16_t* dstb = isk ? Kb : Vb;
                size_t off;
                if (!lat) { const int s = row >> 8; off = ((size_t)(s * 2 + kvh) * 256 + tl) * 64 + sb * 8; }
                else { const int bb = (row - TCTX) >> 11; off = (size_t)KV_LAT_OFF + ((size_t)(bb * 2 + kvh) * 2560 + 512 + tl) * 64 + sb * 8; }
                u32x4 w; w.x = cvt_pk(x[0], x[1]); w.y = cvt_pk(x[2], x[3]); w.z = cvt_pk(x[4], x[5]); w.w = cvt_pk(x[6], x[7]);
                *(u32x4*)(dstb + off) = w;
                if (!lat) {
                    const int s = row >> 8;
                    float* o = p.out + (isk ? OUT_CK : OUT_CV) + ((((size_t)s * 2 + l) * 256 + tl) * 2 + kvh) * 64 + sb * 8;
                    *(f32x4*)o = (f32x4){x[0], x[1], x[2], x[3]}; *(f32x4*)(o + 4) = (f32x4){x[4], x[5], x[6], x[7]};
                }
            }
        }
    }
}
__device__ __forceinline__ void prepc_item(const Params& p, int l, int it) {
    const int tid_ = otid(); const int lane = tid_ & 63, wave = tid_ >> 6;
    bf16_t* Kb = (bf16_t*)(p.ws + WS_K); bf16_t* Vb = (bf16_t*)(p.ws + WS_V);
    for (int r = 0; r < 16; ++r) {
        const int bp = it * 128 + wave * 16 + r;
        const int bb = bp >> 9, pos = bp & 511;
        if (lane < 32) {
            const bool isk = lane < 16; const int ln = lane & 15, kvh = ln >> 3, sb = ln & 7;
            const float* src = (isk ? p.in[2] : p.in[3]) + ((((size_t)bb * 2 + l) * 512 + pos) * 2 + kvh) * 64 + sb * 8;
            const f32x4 a = *(const f32x4*)src, b = *(const f32x4*)(src + 4);
            u32x4 w; w.x = cvt_pk(a[0], a[1]); w.y = cvt_pk(a[2], a[3]); w.z = cvt_pk(b[0], b[1]); w.w = cvt_pk(b[2], b[3]);
            *(u32x4*)((isk ? Kb : Vb) + (size_t)KV_LAT_OFF + ((size_t)(bb * 2 + kvh) * 2560 + pos) * 64 + sb * 8) = w;
        }
    }
}

__device__ __forceinline__ void hgrn_item(const Params& p, int l, int L, int rowbase, int bidx, bool lat, int h, int dir, int eg, LAS unsigned char* lds) {
    const int tid = otid();
    LAS float* qs = (LAS float*)lds;
    LAS float* fs = qs + 4096;
    LAS float* ks = fs + 4096;
    LAS float* vs = ks + 4096;
    LAS float* part = vs + 1024;
    const bf16_t* Z = (const bf16_t*)(p.ws + WS_HZ);
    float* OH = (float*)(p.ws + WS_OH) + (size_t)dir * T * 256;
    const int ss = tid >> 4, sj = tid & 15;
    float lbv[4];
#pragma unroll
    for (int i = 0; i < 4; ++i) {
        const int dd = h * 64 + 4 * sj + i;
        lbv[i] = (l == 0) ? 0.f : 1.0f / (1.0f + __expf(p.in[17][dd] - p.in[17][256 + dd]));
    }
    const int cq = h * 64 + 4 * sj, cf = (dir ? 768 : 512) + h * 64 + 4 * sj, cv = 256 + h * 64 + eg * 16 + sj;
    const int el = tid & 15, dg = tid >> 4;
    float S0 = 0.f, S1 = 0.f;
    if (lat) {
        const float* s0 = p.in[4] + ((((size_t)bidx * 2 + l) * 2 + dir) * 4 + h) * 4096;
        S0 = s0[(2 * dg) * 64 + eg * 16 + el]; S1 = s0[(2 * dg + 1) * 64 + eg * 16 + el];
    }
    const int nb = L >> 5;
    u32x2 rq, rf; unsigned short rv;
#define HG_LOAD(bt) do { const int n_ = (bt) * 32 + ss; const int t_ = dir ? (L - 1 - n_) : n_; const bf16_t* zr_ = Z + (size_t)(rowbase + t_) * NIN; \
        rq = *(const u32x2*)(zr_ + cq); rf = *(const u32x2*)(zr_ + cf); rv = zr_[cv]; } while (0)
#define HG_STAGE(buf) do { const float zq_[4] = {bf_lo(rq.x), bf_hi(rq.x), bf_lo(rq.y), bf_hi(rq.y)}; const float zf_[4] = {bf_lo(rf.x), bf_hi(rf.x), bf_lo(rf.y), bf_hi(rf.y)}; \
        f32x4 fq_, ff_, fk_; _Pragma("unroll") for (int i = 0; i < 4; ++i) { const float f_ = lbv[i] + (1.0f - lbv[i]) * sigmoid_f(zf_[i]); fq_[i] = zq_[i]; ff_[i] = fmaxf(f_, 1e-6f); fk_[i] = 1.0f - f_; } \
        *(LAS f32x4*)(qs + (buf) * 2048 + ss * 64 + 4 * sj) = fq_; *(LAS f32x4*)(fs + (buf) * 2048 + ss * 64 + 4 * sj) = ff_; *(LAS f32x4*)(ks + (buf) * 2048 + ss * 64 + 4 * sj) = fk_; \
        vs[(buf) * 512 + ss * 16 + sj] = __uint_as_float((unsigned)rv << 16); } while (0)
    HG_LOAD(0);
    HG_STAGE(0);
    __syncthreads();
    for (int bt = 0; bt < nb; ++bt) {
        const int cur = bt & 1;
        if (bt + 1 < nb) HG_LOAD(bt + 1);
        const LAS float* q_ = qs + cur * 2048 + 2 * dg; const LAS float* f_ = fs + cur * 2048 + 2 * dg; const LAS float* k_ = ks + cur * 2048 + 2 * dg;
        const LAS float* v_ = vs + cur * 512 + el;
#pragma unroll 8
        for (int s = 0; s < 32; ++s) {
            const f32x2 f2 = *(const LAS f32x2*)(f_ + s * 64), k2 = *(const LAS f32x2*)(k_ + s * 64), q2 = *(const LAS f32x2*)(q_ + s * 64);
            const float v = v_[s * 16];
            S0 = f2[0] * S0 + k2[0] * v; S1 = f2[1] * S1 + k2[1] * v;
            part[s * 528 + tid] = q2[0] * S0 + q2[1] * S1;
        }
        __syncthreads();
        {
            float o = 0.f;
#pragma unroll
            for (int g = 0; g < 32; ++g) o += part[ss * 528 + g * 16 + sj];
            const int n = bt * 32 + ss; const int t = dir ? (L - 1 - n) : n;
            OH[(size_t)(rowbase + t) * 256 + h * 64 + eg * 16 + sj] = o;
        }
        if (bt + 1 < nb) HG_STAGE(cur ^ 1);
        __syncthreads();
    }
#undef HG_LOAD
#undef HG_STAGE
    if (!lat) {
        float* sf = p.out + OUT_ST + ((((size_t)bidx * 2 + l) * 2 + dir) * 4 + h) * 4096;
        sf[(2 * dg) * 64 + eg * 16 + el] = S0; sf[(2 * dg + 1) * 64 + eg * 16 + el] = S1;
    }
}


__device__ __forceinline__ int hg_tt(int r, int u) { return r * 64 + ((u ^ ((r >> 2) & 3)) << 3); }
__device__ __forceinline__ int hg_gs(int e, int u) { return e * 128 + ((u ^ (e & 7)) << 4); }
__device__ __forceinline__ void hgrn_chain(const Params& p, int l, int L, int rowbase, int bidx, bool lat, int h, int dir, LAS unsigned char* lds) {
    const int tid = otid(), lane = tid & 63, wave = tid >> 6;
    const int qr = lane & 15, kq = lane >> 4;
    LAS unsigned char* wb = lds + wave * 17408;
    LAS unsigned char* QT = wb; LAS unsigned char* KT = wb + 4608; LAS unsigned char* KTT = wb + 9216; LAS unsigned char* VT = wb + 13312; LAS unsigned char* GS = wb + 9216;
    LAS float* vec = (LAS float*)(lds + 8 * 17408) + wave * 192;
    const bf16_t* Z = (const bf16_t*)(p.ws + WS_HZ);
    float* OH = (float*)(p.ws + WS_OH) + (size_t)dir * T * 256;
    const int cq = h * 64, cf = (dir ? 768 : 512) + h * 64, cv = 256 + h * 64;
    const float lb = (l == 0) ? 0.f : 1.0f / (1.0f + __expf(p.in[17][h * 64 + lane] - p.in[17][256 + h * 64 + lane]));
    const int e2 = tid >> 3, u2 = tid & 7;
    float S[8];
#pragma unroll
    for (int j = 0; j < 8; ++j) S[j] = 0.f;
    if (lat) {
        const float* s0 = p.in[4] + ((((size_t)bidx * 2 + l) * 2 + dir) * 4 + h) * 4096;
#pragma unroll
        for (int j = 0; j < 8; ++j) S[j] = s0[(8 * u2 + j) * 64 + e2];
    }
    const int nround = L >> 8;
    for (int r = 0; r < nround; ++r) {
        const int n0 = (r * 8 + wave) * 32;
        const int trow0 = dir ? (L - 1 - n0) : n0, tstep = dir ? -1 : 1;
        const bf16_t* zb = Z + (size_t)(rowbase + trow0) * NIN + lane;
        const long zs = (long)tstep * NIN;
        {
            float a[32], kk[32]; float run = 0.f;
#pragma unroll
            for (int t = 0; t < 32; ++t) {
                const float zf = __uint_as_float((unsigned)zb[t * zs + cf] << 16);
                const float f = lb + (1.0f - lb) * sigmoid_f(zf);
                run += __logf(fmaxf(f, 1e-6f)); a[t] = run; kk[t] = 1.0f - f;
            }
            const float aref = a[15], alast = a[31];
            vec[lane] = __expf(alast); vec[64 + lane] = __expf(aref); vec[128 + lane] = __expf(alast - aref);
            unsigned kp[16];
#pragma unroll
            for (int t = 0; t < 32; t += 2) {
                const float x0 = fminf(fmaxf(a[t] - aref, -60.f), 60.f), x1 = fminf(fmaxf(a[t + 1] - aref, -60.f), 60.f);
                const float w0 = __expf(x0), w1 = __expf(x1), i0 = __expf(-x0), i1 = __expf(-x1);
                const float q0 = __uint_as_float((unsigned)zb[t * zs + cq] << 16), q1 = __uint_as_float((unsigned)zb[(t + 1) * zs + cq] << 16);
                const unsigned qp = cvt_pk(q0 * w0, q1 * w1), kpk = cvt_pk(kk[t] * i0, kk[t + 1] * i1);
                *(LAS unsigned short*)(QT + t * 144 + lane * 2) = (unsigned short)(qp & 0xffffu);
                *(LAS unsigned short*)(QT + (t + 1) * 144 + lane * 2) = (unsigned short)(qp >> 16);
                *(LAS unsigned short*)(KT + t * 144 + lane * 2) = (unsigned short)(kpk & 0xffffu);
                *(LAS unsigned short*)(KT + (t + 1) * 144 + lane * 2) = (unsigned short)(kpk >> 16);
                kp[t >> 1] = kpk;
            }
#pragma unroll
            for (int u = 0; u < 8; ++u) *(LAS u32x2*)(KTT + hg_tt(lane, u)) = (u32x2){kp[2 * u], kp[2 * u + 1]};
        }
        {
            unsigned vp[16];
#pragma unroll
            for (int t = 0; t < 32; t += 2) vp[t >> 1] = (unsigned)zb[t * zs + cv] | ((unsigned)zb[(t + 1) * zs + cv] << 16);
#pragma unroll
            for (int u = 0; u < 8; ++u) *(LAS u32x2*)(VT + hg_tt(lane, u)) = (u32x2){vp[2 * u], vp[2 * u + 1]};
        }
        asm volatile("s_waitcnt lgkmcnt(0)" ::: "memory");
        f32x4 o[4][2];
        {
            bf16x8 qf[2][2], kf[2][2];
#pragma unroll
            for (int tt = 0; tt < 2; ++tt)
#pragma unroll
                for (int ks = 0; ks < 2; ++ks) {
                    qf[tt][ks] = *(const LAS bf16x8*)(QT + (16 * tt + qr) * 144 + ks * 64 + kq * 16);
                    kf[tt][ks] = *(const LAS bf16x8*)(KT + (16 * tt + qr) * 144 + ks * 64 + kq * 16);
                }
            const f32x4 zero = {0.f, 0.f, 0.f, 0.f};
            f32x4 p00 = __builtin_amdgcn_mfma_f32_16x16x32_bf16(kf[0][0], qf[0][0], zero, 0, 0, 0);
            p00 = __builtin_amdgcn_mfma_f32_16x16x32_bf16(kf[0][1], qf[0][1], p00, 0, 0, 0);
            f32x4 p01 = __builtin_amdgcn_mfma_f32_16x16x32_bf16(kf[0][0], qf[1][0], zero, 0, 0, 0);
            p01 = __builtin_amdgcn_mfma_f32_16x16x32_bf16(kf[0][1], qf[1][1], p01, 0, 0, 0);
            f32x4 p11 = __builtin_amdgcn_mfma_f32_16x16x32_bf16(kf[1][0], qf[1][0], zero, 0, 0, 0);
            p11 = __builtin_amdgcn_mfma_f32_16x16x32_bf16(kf[1][1], qf[1][1], p11, 0, 0, 0);
#pragma unroll
            for (int j = 0; j < 4; ++j) { const bool keep = (4 * kq + j) <= qr; p00[j] = keep ? p00[j] : 0.f; p11[j] = keep ? p11[j] : 0.f; }
            u32x4 w0, w1;
            w0.x = cvt_pk_b(p00[0], p00[1]); w0.y = cvt_pk_b(p00[2], p00[3]); w0.z = 0u; w0.w = 0u;
            w1.x = cvt_pk_b(p01[0], p01[1]); w1.y = cvt_pk_b(p01[2], p01[3]); w1.z = cvt_pk_b(p11[0], p11[1]); w1.w = cvt_pk_b(p11[2], p11[3]);
            const bf16x8 pb0 = __builtin_bit_cast(bf16x8, w0), pb1 = __builtin_bit_cast(bf16x8, w1);
            bf16x8 va[4], ka[4];
#pragma unroll
            for (int i = 0; i < 4; ++i) {
                const int row = 16 * i + qr;
                const u32x2 vlo = *(const LAS u32x2*)(VT + hg_tt(row, kq)), vhi = *(const LAS u32x2*)(VT + hg_tt(row, 4 + kq));
                const u32x2 klo = *(const LAS u32x2*)(KTT + hg_tt(row, kq)), khi = *(const LAS u32x2*)(KTT + hg_tt(row, 4 + kq));
                va[i] = __builtin_bit_cast(bf16x8, (u32x4){vlo.x, vlo.y, vhi.x, vhi.y});
                ka[i] = __builtin_bit_cast(bf16x8, (u32x4){klo.x, klo.y, khi.x, khi.y});
            }
            asm volatile("s_waitcnt lgkmcnt(0)" ::: "memory");
#pragma unroll
            for (int et = 0; et < 4; ++et) {
                o[et][0] = __builtin_amdgcn_mfma_f32_16x16x32_bf16(va[et], pb0, zero, 0, 0, 0);
                o[et][1] = __builtin_amdgcn_mfma_f32_16x16x32_bf16(va[et], pb1, zero, 0, 0, 0);
            }
#pragma unroll
            for (int dt = 0; dt < 4; ++dt) {
                const f32x4 Fv = *(const LAS f32x4*)(vec + 128 + 16 * dt + 4 * kq);
#pragma unroll
                for (int et = 0; et < 4; ++et) {
                    f32x4 rt = __builtin_amdgcn_mfma_f32_16x16x32_bf16(ka[dt], va[et], zero, 0, 0, 0);
                    rt = rt * Fv;
                    u32x2 w; w.x = cvt_pk(rt[0], rt[1]); w.y = cvt_pk(rt[2], rt[3]);
                    *(LAS u32x2*)(GS + hg_gs(16 * et + qr, 2 * dt + (kq >> 1)) + (kq & 1) * 8) = w;
                }
            }
        }
        __syncthreads();
#pragma unroll 1
        for (int w = 0; w < 8; ++w) {
            LAS unsigned char* gsw = lds + w * 17408 + 9216 + hg_gs(e2, u2);
            const LAS float* vw = (const LAS float*)(lds + 8 * 17408) + w * 192 + 8 * u2;
            const u32x4 g = *(const LAS u32x4*)gsw;
            const f32x4 d0 = *(const LAS f32x4*)vw, d1 = *(const LAS f32x4*)(vw + 4), E0 = *(const LAS f32x4*)(vw + 64), E1 = *(const LAS f32x4*)(vw + 68);
            u32x4 sp;
            sp.x = cvt_pk(S[0] * E0[0], S[1] * E0[1]); sp.y = cvt_pk(S[2] * E0[2], S[3] * E0[3]); sp.z = cvt_pk(S[4] * E1[0], S[5] * E1[1]); sp.w = cvt_pk(S[6] * E1[2], S[7] * E1[3]);
            *(LAS u32x4*)gsw = sp;
            S[0] = d0[0] * S[0] + bf_lo(g.x); S[1] = d0[1] * S[1] + bf_hi(g.x); S[2] = d0[2] * S[2] + bf_lo(g.y); S[3] = d0[3] * S[3] + bf_hi(g.y);
            S[4] = d1[0] * S[4] + bf_lo(g.z); S[5] = d1[1] * S[5] + bf_hi(g.z); S[6] = d1[2] * S[6] + bf_lo(g.w); S[7] = d1[3] * S[7] + bf_hi(g.w);
        }
        __syncthreads();
        {
            bf16x8 qf[2][2];
#pragma unroll
            for (int tt = 0; tt < 2; ++tt)
#pragma unroll
                for (int ks = 0; ks < 2; ++ks) qf[tt][ks] = *(const LAS bf16x8*)(QT + (16 * tt + qr) * 144 + ks * 64 + kq * 16);
#pragma unroll
            for (int et = 0; et < 4; ++et)
#pragma unroll
                for (int ks = 0; ks < 2; ++ks) {
                    const bf16x8 sa = *(const LAS bf16x8*)(GS + hg_gs(16 * et + qr, 4 * ks + kq));
                    o[et][0] = __builtin_amdgcn_mfma_f32_16x16x32_bf16(sa, qf[0][ks], o[et][0], 0, 0, 0);
                    o[et][1] = __builtin_amdgcn_mfma_f32_16x16x32_bf16(sa, qf[1][ks], o[et][1], 0, 0, 0);
                }
#pragma unroll
            for (int tt = 0; tt < 2; ++tt) {
                const int n = 16 * tt + qr;
                float* orow = OH + (size_t)(rowbase + trow0 + tstep * n) * 256 + h * 64 + 4 * kq;
#pragma unroll
                for (int et = 0; et < 4; ++et) *(f32x4*)(orow + 16 * et) = o[et][tt];
            }
        }
        asm volatile("s_waitcnt lgkmcnt(0)" ::: "memory");
    }
    if (!lat) {
        float* sf = p.out + OUT_ST + ((((size_t)bidx * 2 + l) * 2 + dir) * 4 + h) * 4096;
#pragma unroll
        for (int j = 0; j < 8; ++j) sf[(8 * u2 + j) * 64 + e2] = S[j];
    }
}

__device__ __forceinline__ void hfin_item(const Params& p, int l, int it) {
    const int tid_ = otid(); const int lane = tid_ & 63, wave = tid_ >> 6;
    const bf16_t* Z = (const bf16_t*)(p.ws + WS_HZ); const float* OH = (const float*)(p.ws + WS_OH); bf16_t* O = (bf16_t*)(p.ws + WS_A);
    const f32x4 g = *(const f32x4*)(p.in[18] + l * 256 + lane * 4);
    for (int r8 = 0; r8 < 8; ++r8) {
        const int row = it * 64 + wave * 8 + r8;
        const f32x4 a = *(const f32x4*)(OH + (size_t)row * 256 + lane * 4) + *(const f32x4*)(OH + (size_t)T * 256 + (size_t)row * 256 + lane * 4);
        float ss = (a[0] * a[0] + a[1] * a[1]) + (a[2] * a[2] + a[3] * a[3]);
        ss += __shfl_xor(ss, 1); ss += __shfl_xor(ss, 2); ss += __shfl_xor(ss, 4); ss += __shfl_xor(ss, 8);
        const float rr = 1.0f / sqrtf(ss * (1.0f / 64.0f) + 1e-6f);
        const u32x2 z = *(const u32x2*)(Z + (size_t)row * NIN + 1024 + lane * 4);
        const float o0 = a[0] * rr * g[0] * silu_f(bf_lo(z.x)), o1 = a[1] * rr * g[1] * silu_f(bf_hi(z.x));
        const float o2 = a[2] * rr * g[2] * silu_f(bf_lo(z.y)), o3 = a[3] * rr * g[3] * silu_f(bf_hi(z.y));
        u32x2 w; w.x = cvt_pk(o0, o1); w.y = cvt_pk(o2, o3);
        *(u32x2*)(O + (size_t)row * D + lane * 4) = w;
    }
}

__device__ __forceinline__ void conv_item(const Params& p, int l, int it, LAS unsigned char* lds) {
    const int tid = otid(), lane = tid & 63, wave = tid >> 6;
    LAS float* ul = (LAS float*)lds;
    LAS float* res = ul + 62 * 256;
    const bf16_t* Z = (const bf16_t*)(p.ws + WS_HZ); bf16_t* O = (bf16_t*)(p.ws + WS_A);
    const int row0 = it * 32;
    int seq0, L;
    if (row0 < TCTX) { seq0 = row0 & ~255; L = 256; } else { seq0 = TCTX + ((row0 - TCTX) & ~2047); L = 2048; }
    for (int i = tid; i < 62 * 32; i += NTHREADS) {
        const int rr = i >> 5, ch = (i & 31) * 8;
        const int prow = row0 - 15 + rr;
        f32x4 u0 = {0.f, 0.f, 0.f, 0.f}, u1 = u0;
        if (prow >= seq0 && prow < seq0 + L) {
            const u32x4 a = *(const u32x4*)(Z + (size_t)prow * NIN + 1280 + ch), b = *(const u32x4*)(Z + (size_t)prow * NIN + 1536 + ch);
            u0[0] = bf_lo(a.x) * sigmoid_f(bf_lo(b.x)); u0[1] = bf_hi(a.x) * sigmoid_f(bf_hi(b.x));
            u0[2] = bf_lo(a.y) * sigmoid_f(bf_lo(b.y)); u0[3] = bf_hi(a.y) * sigmoid_f(bf_hi(b.y));
            u1[0] = bf_lo(a.z) * sigmoid_f(bf_lo(b.z)); u1[1] = bf_hi(a.z) * sigmoid_f(bf_hi(b.z));
            u1[2] = bf_lo(a.w) * sigmoid_f(bf_lo(b.w)); u1[3] = bf_hi(a.w) * sigmoid_f(bf_hi(b.w));
        }
        *(LAS f32x4*)(ul + rr * 256 + ch) = u0; *(LAS f32x4*)(ul + rr * 256 + ch + 4) = u1;
    }
    __syncthreads();
    {
        const int c = tid & 255, half = tid >> 8;
        float w[31];
#pragma unroll
        for (int j = 0; j < 31; ++j) w[j] = p.in[19][((size_t)l * 31 + j) * 256 + c];
        const float bias = p.in[20][l * 256 + c];
        float uu[46];
#pragma unroll
        for (int i = 0; i < 46; ++i) uu[i] = ul[(half * 16 + i) * 256 + c];
#pragma unroll
        for (int pp = 0; pp < 16; ++pp) {
            float acc = bias;
#pragma unroll
            for (int j = 0; j < 31; ++j) acc += w[j] * uu[pp + j];
            res[(half * 16 + pp) * 256 + c] = acc;
        }
    }
    __syncthreads();
    {
        const f32x4 g = *(const f32x4*)(p.in[21] + l * 256 + lane * 4), b = *(const f32x4*)(p.in[22] + l * 256 + lane * 4);
#pragma unroll
        for (int r = 0; r < 4; ++r) {
            const int pp = wave * 4 + r;
            f32x4 x = *(const LAS f32x4*)(res + pp * 256 + lane * 4);
            const float mean = wave_sum((x[0] + x[1]) + (x[2] + x[3])) * (1.0f / 256.0f);
            x = x - mean;
            const float var = wave_sum((x[0] * x[0] + x[1] * x[1]) + (x[2] * x[2] + x[3] * x[3])) * (1.0f / 256.0f);
            const float rstd = 1.0f / sqrtf(var + 1e-5f);
            x = x * rstd * g + b;
            u32x2 w; w.x = cvt_pk(silu_f(x[0]), silu_f(x[1])); w.y = cvt_pk(silu_f(x[2]), silu_f(x[3]));
            *(u32x2*)(O + (size_t)(row0 + pp) * D + 256 + lane * 4) = w;
        }
    }
}

template <int NQ>
__device__ __forceinline__ void attn_item(const bf16_t* Qb, const bf16_t* Kp, const bf16_t* Vp, int Lk, int qrow0, int kvh, bf16_t* O, LAS unsigned char* lds) {
    const int tid = otid(), lane = tid & 63, wave = tid >> 6;
    const int g = wave >> 1, sub = wave & 1, head = kvh * 4 + g;
    const int qr = lane & 15, kq = lane >> 4;
    bf16x8 qf[NQ][2];
#pragma unroll
    for (int qi = 0; qi < NQ; ++qi) {
        const int row = qrow0 + sub * (16 * NQ) + qi * 16 + qr;
#pragma unroll
        for (int ks = 0; ks < 2; ++ks) qf[qi][ks] = *(const bf16x8*)(Qb + (size_t)row * 512 + head * 64 + ks * 32 + kq * 8);
    }
    f32x4 o[NQ][4]; float mrun[NQ], lsum[NQ];
#pragma unroll
    for (int qi = 0; qi < NQ; ++qi) { mrun[qi] = -1e30f; lsum[qi] = 0.f;
#pragma unroll
        for (int dt = 0; dt < 4; ++dt) o[qi][dt] = (f32x4){0.f, 0.f, 0.f, 0.f}; }
    const int skey = tid >> 3, sch = tid & 7;
    const int ntile = Lk >> 6;
    u32x4 rk = *(const u32x4*)(Kp + (size_t)skey * 64 + sch * 8), rv = *(const u32x4*)(Vp + (size_t)skey * 64 + sch * 8);
#define AT_KBUF(b) (lds + (b) * 9216)
#define AT_VBUF(b) (lds + 18432 + (b) * 8704)
#define AT_STAGE(b) do { *(LAS u32x4*)(AT_KBUF(b) + skey * 144 + sch * 16) = rk; LAS unsigned short* vt_ = (LAS unsigned short*)(AT_VBUF(b) + (sch * 8) * 136 + skey * 2); \
        vt_[0 * 68] = (unsigned short)(rv.x & 0xffffu); vt_[1 * 68] = (unsigned short)(rv.x >> 16); vt_[2 * 68] = (unsigned short)(rv.y & 0xffffu); vt_[3 * 68] = (unsigned short)(rv.y >> 16); \
        vt_[4 * 68] = (unsigned short)(rv.z & 0xffffu); vt_[5 * 68] = (unsigned short)(rv.z >> 16); vt_[6 * 68] = (unsigned short)(rv.w & 0xffffu); vt_[7 * 68] = (unsigned short)(rv.w >> 16); } while (0)
    AT_STAGE(0);
    __syncthreads();
    for (int kt = 0; kt < ntile; ++kt) {
        const int cur = kt & 1;
        if (kt + 1 < ntile) { rk = *(const u32x4*)(Kp + (size_t)((kt + 1) * 64 + skey) * 64 + sch * 8); rv = *(const u32x4*)(Vp + (size_t)((kt + 1) * 64 + skey) * 64 + sch * 8); }
        f32x4 s[NQ][4];
        const LAS unsigned char* kb = AT_KBUF(cur);
#pragma unroll
        for (int t4 = 0; t4 < 4; ++t4) {
            const bf16x8 ka0 = *(const LAS bf16x8*)(kb + (t4 * 16 + qr) * 144 + kq * 16);
            const bf16x8 ka1 = *(const LAS bf16x8*)(kb + (t4 * 16 + qr) * 144 + 64 + kq * 16);
#pragma unroll
            for (int qi = 0; qi < NQ; ++qi) {
                f32x4 z = {0.f, 0.f, 0.f, 0.f};
                z = __builtin_amdgcn_mfma_f32_16x16x32_bf16(ka0, qf[qi][0], z, 0, 0, 0);
                s[qi][t4] = __builtin_amdgcn_mfma_f32_16x16x32_bf16(ka1, qf[qi][1], z, 0, 0, 0);
            }
        }
        bf16x8 pb[NQ][2];
#pragma unroll
        for (int qi = 0; qi < NQ; ++qi) {
            float mx = -1e30f;
#pragma unroll
            for (int t4 = 0; t4 < 4; ++t4) mx = fmaxf(mx, fmaxf(fmaxf(s[qi][t4][0], s[qi][t4][1]), fmaxf(s[qi][t4][2], s[qi][t4][3])));
            mx = fmaxf(mx, __shfl_xor(mx, 16)); mx = fmaxf(mx, __shfl_xor(mx, 32));
            const float mnew = fmaxf(mrun[qi], mx);
            const float alpha = __builtin_amdgcn_exp2f(mrun[qi] - mnew);
            mrun[qi] = mnew;
            float psum = 0.f;
#pragma unroll
            for (int t4 = 0; t4 < 4; ++t4)
#pragma unroll
                for (int j = 0; j < 4; ++j) { const float pv = __builtin_amdgcn_exp2f(s[qi][t4][j] - mnew); s[qi][t4][j] = pv; psum += pv; }
            lsum[qi] = lsum[qi] * alpha + psum;
#pragma unroll
            for (int dt = 0; dt < 4; ++dt) o[qi][dt] = o[qi][dt] * alpha;
#pragma unroll
            for (int kp = 0; kp < 2; ++kp) {
                u32x4 w; w.x = cvt_pk_c(s[qi][2 * kp][0], s[qi][2 * kp][1]); w.y = cvt_pk_c(s[qi][2 * kp][2], s[qi][2 * kp][3]);
                w.z = cvt_pk_c(s[qi][2 * kp + 1][0], s[qi][2 * kp + 1][1]); w.w = cvt_pk_c(s[qi][2 * kp + 1][2], s[qi][2 * kp + 1][3]);
                pb[qi][kp] = __builtin_bit_cast(bf16x8, w);
            }
        }
        const LAS unsigned char* vb = AT_VBUF(cur);
#pragma unroll
        for (int dt = 0; dt < 4; ++dt)
#pragma unroll
            for (int kp = 0; kp < 2; ++kp) {
                const u32x2 lo = *(const LAS u32x2*)(vb + (dt * 16 + qr) * 136 + ((2 * kp) * 16 + kq * 4) * 2);
                const u32x2 hi = *(const LAS u32x2*)(vb + (dt * 16 + qr) * 136 + ((2 * kp + 1) * 16 + kq * 4) * 2);
                const u32x4 w = {lo.x, lo.y, hi.x, hi.y};
                const bf16x8 va = __builtin_bit_cast(bf16x8, w);
#pragma unroll
                for (int qi = 0; qi < NQ; ++qi) o[qi][dt] = __builtin_amdgcn_mfma_f32_16x16x32_bf16(va, pb[qi][kp], o[qi][dt], 0, 0, 0);
            }
        if (kt + 1 < ntile) AT_STAGE(cur ^ 1);
        __syncthreads();
    }
#undef AT_STAGE
#undef AT_KBUF
#undef AT_VBUF
#pragma unroll
    for (int qi = 0; qi < NQ; ++qi) {
        float ls = lsum[qi]; ls += __shfl_xor(ls, 16); ls += __shfl_xor(ls, 32);
        const float inv = 1.0f / ls;
        const int row = qrow0 + sub * (16 * NQ) + qi * 16 + qr;
#pragma unroll
        for (int dt = 0; dt < 4; ++dt) {
            const f32x4 v = o[qi][dt] * inv;
            u32x2 w; w.x = cvt_pk_c(v[0], v[1]); w.y = cvt_pk_c(v[2], v[3]);
            *(u32x2*)(O + (size_t)row * D + 512 + head * 64 + dt * 16 + kq * 4) = w;
        }
    }
}

__device__ __forceinline__ void mix_a(const Params& p, int l, unsigned* ctr, LAS unsigned char* lds) {
    LAS int* slot = (LAS int*)(lds + LDS_BYTES - 64);
    constexpr int N_HL = 16, N_HC = 256, N_CV = 384, N_PR = 192, N_PC = 8, TOT = N_HL + N_HC + N_CV + N_PR + N_PC;
    int qk = 0;
    for (;;) {
        int it = next_item(ctr, slot, qk);
        if (it >= TOT) break;
        if (it < N_HL) { const int dir = it & 1, h = (it >> 1) & 3, b = it >> 3; hgrn_chain(p, l, 2048, TCTX + b * 2048, b, true, h, dir, lds); continue; }
        it -= N_HL;
        if (it < N_HC) { const int dir = it & 1, h = (it >> 1) & 3, s = it >> 3; hgrn_chain(p, l, 256, s * 256, s, false, h, dir, lds); continue; }
        it -= N_HC;
        if (it < N_CV) { conv_item(p, l, it, lds); continue; }
        it -= N_CV;
        if (it < N_PR) { prep_item(p, l, it); continue; }
        it -= N_PR;
        prepc_item(p, l, it);
    }
}
__device__ __forceinline__ void mix_b(const Params& p, int l, unsigned* ctr, LAS unsigned char* lds) {
    LAS int* slot = (LAS int*)(lds + LDS_BYTES - 64);
    constexpr int N_AL = 256, N_AC = 256, N_HF = 192, TOT = N_AL + N_AC + N_HF;
    const bf16_t* Qb = (const bf16_t*)(p.ws + WS_Q); const bf16_t* Kb = (const bf16_t*)(p.ws + WS_K); const bf16_t* Vb = (const bf16_t*)(p.ws + WS_V);
    bf16_t* O = (bf16_t*)(p.ws + WS_A);
    int qk = 0;
    for (;;) {
        int it = next_item(ctr, slot, qk);
        if (it >= TOT) break;
        if (it < N_AL) {
            const int qt = it & 63, kvh = (it >> 6) & 1, b = it >> 7;
            const size_t off = (size_t)KV_LAT_OFF + (size_t)(b * 2 + kvh) * 2560 * 64;
            if (EN_MASK & 64) attn_item<1>(Qb, Kb + off, Vb + off, 2560, TCTX + b * 2048 + qt * 32, kvh, O, lds);
            continue;
        }
        it -= N_AL;
        if (it < N_AC) {
            const int qt = it & 3, kvh = (it >> 2) & 1, s = it >> 3;
            const size_t off = (size_t)(s * 2 + kvh) * 256 * 64;
            if (EN_MASK & 128) attn_item<2>(Qb, Kb + off, Vb + off, 256, s * 256 + qt * 64, kvh, O, lds);
            continue;
        }
        it -= N_AC;
        if (EN_MASK & 256) hfin_item(p, l, it);
    }
}

#define XB_TMO      128
#define XB_XCNT(j)  (256  + 64 * (j))
#define XB_XSUB(j)  (1280 + 64 * (j))
#define XB_XGEN(j)  (2304 + 64 * (j))
#define XB_TOP      3328
#define XB_TOPGEN   3392
#define XCD_BAR_WORDS 3456
#define XB_SPIN_CAP (1u << 18)

__device__ __forceinline__ unsigned xb_ld(unsigned* p)              { return __hip_atomic_load(p, __ATOMIC_RELAXED, __HIP_MEMORY_SCOPE_AGENT); }
__device__ __forceinline__ unsigned xb_add(unsigned* p, unsigned v) { return __hip_atomic_fetch_add(p, v, __ATOMIC_RELAXED, __HIP_MEMORY_SCOPE_AGENT); }
__device__ __forceinline__ unsigned xb_xcc_id() { return (unsigned)__builtin_amdgcn_s_getreg((3 << 11) | 20) & 0xFu; }
#define XB_SPIN(cond, bar) do { unsigned _sp = 0; while (cond) { __builtin_amdgcn_s_sleep(1); \
    if ((++_sp & 255u) == 0u) { if (xb_ld(&(bar)[XB_TMO])) break; if (_sp > XB_SPIN_CAP) { atomicAdd(&(bar)[XB_TMO], 1u); break; } } } } while (0)

struct XcdBarrier {
    unsigned* bar; unsigned x;
    volatile LAS unsigned* st;
};

__device__ __forceinline__ XcdBarrier xcd_barrier_post(unsigned* bar, volatile LAS unsigned* st) {
    XcdBarrier b; b.bar = bar; b.x = xb_xcc_id(); b.st = st;
    if (threadIdx.x == 0) (void)xb_add(&bar[XB_XCNT(b.x)], 1u);
    return b;
}
__device__ __forceinline__ void xcd_barrier_complete(unsigned* bar, unsigned x, unsigned& nloc, unsigned& nx) {
    const unsigned G = gridDim.x * gridDim.y * gridDim.z;
    unsigned sum, cnt, mine, sp = 0u;
    for (;;) {
        sum = 0u; cnt = 0u; mine = 0u;
#pragma unroll
        for (unsigned j = 0; j < 16; ++j) { const unsigned c = xb_ld(&bar[XB_XCNT(j)]); sum += c; cnt += (c > 0u) ? 1u : 0u; mine = (j == x) ? c : mine; }
        if (sum == G) break;
        __builtin_amdgcn_s_sleep(1);
        if ((++sp & 255u) == 0u) { if (xb_ld(&bar[XB_TMO])) break; if (sp > XB_SPIN_CAP) { atomicAdd(&bar[XB_TMO], 1u); break; } }
    }
    nloc = mine > 0u ? mine : 1u; nx = cnt > 0u ? cnt : 1u;
}

__device__ __forceinline__ void xcd_barrier(const XcdBarrier& b) {
    asm volatile("s_waitcnt vmcnt(0)" ::: "memory");
    __syncthreads();
    if (threadIdx.x == 0) {
        unsigned* bar = b.bar;
        __builtin_amdgcn_s_waitcnt(0);
        unsigned nloc = b.st[0], nx = b.st[1];
        if (nloc == 0u) { xcd_barrier_complete(bar, b.x, nloc, nx); b.st[0] = nloc; b.st[1] = nx; }
        const unsigned old = xb_add(&bar[XB_XSUB(b.x)], 1u);
        const unsigned gen = old / nloc;
        if (old + 1u == (gen + 1u) * nloc) {
            __builtin_amdgcn_fence(__ATOMIC_RELEASE, "agent");
            asm volatile("s_waitcnt vmcnt(0)" ::: "memory");
            const unsigned og = xb_add(&bar[XB_TOP], 1u);
            const unsigned tg = og / nx;
            if (og + 1u == (tg + 1u) * nx) xb_add(&bar[XB_TOPGEN], 1u);
            else XB_SPIN(xb_ld(&bar[XB_TOPGEN]) == tg, bar);
            __builtin_amdgcn_fence(__ATOMIC_ACQUIRE, "agent");
            xb_add(&bar[XB_XGEN(b.x)], 1u);
            asm volatile("s_waitcnt vmcnt(0)" ::: "memory");
        } else {
            XB_SPIN(xb_ld(&bar[XB_XGEN(b.x)]) == gen, bar);
            __builtin_amdgcn_fence(__ATOMIC_ACQUIRE, "agent");
            asm volatile("s_waitcnt vmcnt(0)" ::: "memory");
        }
    }
    __syncthreads();
}

__global__ void __launch_bounds__(NTHREADS, 2) fwd_megakernel(Params p) {
    extern __shared__ __attribute__((aligned(16))) unsigned char lds_raw[];
    LAS unsigned char* lds = (LAS unsigned char*)lds_raw;
    cg::grid_group grid = cg::this_grid();
#define GSYNC1() xcd_barrier(xbar)
#define GSYNC() do { GSYNC1(); if (REP_MASK & 32) GSYNC1(); } while (0)
    const int G = gridDim.x, c = blockIdx.x;
    unsigned* ctl = (unsigned*)(p.ws + WS_CTL);
    { volatile LAS unsigned* st0 = (volatile LAS unsigned*)(lds + LDS_BYTES - 32); if (threadIdx.x < 2) st0[threadIdx.x] = 0u; }
    __syncthreads();
    grid.sync();
    const XcdBarrier xbar = xcd_barrier_post(ctl + 1024, (volatile LAS unsigned*)(lds + LDS_BYTES - 32));
    float* X = (float*)(p.ws + WS_X);
    const bf16_t* A = (const bf16_t*)(p.ws + WS_A);
    bf16_t* HZ = (bf16_t*)(p.ws + WS_HZ);
    const float* MOD = (const float*)(p.ws + WS_MOD);

    if (EN_MASK & 32) prologue(p, lds);
    if (REP_MASK & 1) { __syncthreads(); prologue(p, lds); }
    GSYNC();
    init_rows(p);
    GSYNC();
#pragma unroll 1
    for (int l = 0; l < 2; ++l) {
        const unsigned char* wl = p.ws + WS_W + (size_t)l * W_LAYER;
        const float* modl = MOD + (size_t)l * 3 * NMOD;
        { pg8::Gemm g{A, (const bf16_t*)(wl + W_1IN), T, 2 * DFF, D}; pg8::StaticOrder S; S.init(T, 2 * DFF, G, c); EpiSwiglu E{HZ};
          if (EN_MASK & 1) pg8::gemm_phase<EpiSwiglu, pg8::StaticOrder, true, true>(lds, g, S, E);
          if (REP_MASK & 2) pg8::gemm_phase<EpiSwiglu, pg8::StaticOrder, true, true>(lds, g, S, E); }
        GSYNC();
        { pg8::Gemm g{HZ, (const bf16_t*)(wl + W_1OUT), T, D, DFF}; pg8::StaticOrder S; S.init(T, D, G, c); EpiResid E{X, modl + 2 * 1024, 0.5f};
          if (EN_MASK & 2) pg8::gemm_phase<EpiResid, pg8::StaticOrder, true, true>(lds, g, S, E); }
        GSYNC();
        ln_rows(p, p.in[9] + (size_t)(l * 3 + 0) * D, p.in[10] + (size_t)(l * 3 + 0) * D, modl, 3, nullptr);
        GSYNC();
        { pg8::Gemm g{A, (const bf16_t*)(wl + W_IN), T, NIN, D}; pg8::StaticOrder S; S.init(T, NIN, G, c); EpiZ E{HZ, NIN};
          if (EN_MASK & 4) pg8::gemm_phase<EpiZ, pg8::StaticOrder, true, true>(lds, g, S, E);
          if (REP_MASK & 4) pg8::gemm_phase<EpiZ, pg8::StaticOrder, true, true>(lds, g, S, E); }
        GSYNC();
        if (EN_MASK & 8) mix_a(p, l, ctl + 64 * (2 * l), lds);
        if (REP_MASK & 8) mix_a(p, l, ctl + 64 * (2 * l), lds);
        GSYNC();
        if (EN_MASK & 16) mix_b(p, l, ctl + 64 * (2 * l + 1), lds);
        if (REP_MASK & 16) mix_b(p, l, ctl + 64 * (2 * l + 1), lds);
        GSYNC();
        { pg8::Gemm g{A, (const bf16_t*)(wl + W_OUT), T, D, D}; pg8::StaticOrder S; S.init(T, D, G, c); EpiResid E{X, modl + 5 * 1024, 1.0f};
          if (EN_MASK & 2) pg8::gemm_phase<EpiResid, pg8::StaticOrder, true, true>(lds, g, S, E); }
        GSYNC();
        ln_rows(p, p.in[9] + (size_t)(l * 3 + 1) * D, p.in[10] + (size_t)(l * 3 + 1) * D, modl, 6, nullptr);
        GSYNC();
        { pg8::Gemm g{A, (const bf16_t*)(wl + W_2IN), T, 2 * DFF, D}; pg8::StaticOrder S; S.init(T, 2 * DFF, G, c); EpiSwiglu E{HZ};
          if (EN_MASK & 1) pg8::gemm_phase<EpiSwiglu, pg8::StaticOrder, true, true>(lds, g, S, E);
          if (REP_MASK & 2) pg8::gemm_phase<EpiSwiglu, pg8::StaticOrder, true, true>(lds, g, S, E); }
        GSYNC();
        { pg8::Gemm g{HZ, (const bf16_t*)(wl + W_2OUT), T, D, DFF}; pg8::StaticOrder S; S.init(T, D, G, c); EpiResid E{X, modl + 8 * 1024, 0.5f};
          if (EN_MASK & 2) pg8::gemm_phase<EpiResid, pg8::StaticOrder, true, true>(lds, g, S, E); }
        GSYNC();
        if (l == 0) {
            ln_rows(p, p.in[9] + (size_t)(l * 3 + 2) * D, p.in[10] + (size_t)(l * 3 + 2) * D, MOD + (size_t)3 * NMOD, 0, nullptr);
            GSYNC();
        } else {
            ln_rows(p, p.in[9] + (size_t)(l * 3 + 2) * D, p.in[10] + (size_t)(l * 3 + 2) * D, MOD, 0, p.out + OUT_Y);
        }
    }
}

extern "C" void kernel_launch(void* const* d_in, const int* in_sizes, int n_in, void* d_out, int out_size, void* d_ws, size_t ws_size, hipStream_t stream) {
    static int grid_blocks = 0;
    if (grid_blocks == 0) {
        if (n_in != 25 || ws_size < WS_END) { fprintf(stderr, "kernel_launch: unexpected n_in %d or ws_size %zu (< %zu)\n", n_in, ws_size, (size_t)WS_END); grid_blocks = -1; return; }
        int dev = 0, cus = 0, per_cu = 0;
        hipGetDevice(&dev);
        hipDeviceGetAttribute(&cus, hipDeviceAttributeMultiprocessorCount, dev);
        if (hipFuncSetAttribute((const void*)fwd_megakernel, hipFuncAttributeMaxDynamicSharedMemorySize, LDS_BYTES) != hipSuccess) { fprintf(stderr, "kernel_launch: hipFuncSetAttribute failed\n"); grid_blocks = -1; return; }
        if (hipOccupancyMaxActiveBlocksPerMultiprocessor(&per_cu, (const void*)fwd_megakernel, NTHREADS, LDS_BYTES) != hipSuccess || per_cu < 1) { fprintf(stderr, "kernel_launch: occupancy query failed (%d)\n", per_cu); per_cu = 1; }
        (void)hipGetLastError();
        grid_blocks = cus * per_cu;
    }
    if (grid_blocks < 0) return;
    hipMemsetAsync((char*)d_ws + WS_CTL, 0, CTL_BYTES, stream);
    Params p{};
    for (int i = 0; i < 25; ++i) p.in[i] = (const float*)d_in[i];
    p.out = (float*)d_out; p.ws = (unsigned char*)d_ws;
    void* args[] = {&p};
    hipError_t e = hipLaunchCooperativeKernel((const void*)fwd_megakernel, dim3(grid_blocks), dim3(NTHREADS), args, LDS_BYTES, stream);
    if (e != hipSuccess) fprintf(stderr, "cooperative launch failed: %s (grid %d)\n", hipGetErrorString(e), grid_blocks);
}
```

```cpp
#include <hip/hip_runtime.h>
#include <hip/hip_cooperative_groups.h>
#include <cstdio>
#include <cstdint>
namespace cg = cooperative_groups;
namespace pg8 {
#define PG8_LAS __attribute__((address_space(3)))
typedef unsigned short bf16_t;
typedef short bf16x8 __attribute__((ext_vector_type(8)));
typedef float f32x4 __attribute__((ext_vector_type(4)));
typedef unsigned u32x4 __attribute__((ext_vector_type(4)));
constexpr int BM = 256, BK = 64, HALF = 128, HTB = HALF * BK * 2  , STAGE_BYTES = 8 * HTB, NXCD = 8, WGM = 8;

__host__ __device__ __forceinline__ int lds_byte(int r, int c) { const int st = (r >> 4) * 2 + (c >> 5), rr = r & 15, cc = c & 31, ob = rr * 64 + cc * 2; return st * 1024 + (ob ^ (((ob >> 9) & 1) << 5)); }
__host__ __device__ __forceinline__ void stage_rc(int b, int& R, int& C) { const int st = b / 1024, sb = b % 1024, swz = sb ^ (((sb >> 9) & 1) << 5); R = (st >> 1) * 16 + swz / 64; C = (st & 1) * 32 + (swz % 64) / 2; }
__host__ __device__ __forceinline__ int perm32(int rho) { const int n = rho >> 4, i = rho & 15; return 8 * (i >> 2) + 4 * n + (i & 3); }

struct Unit { int pm, pn; };
struct Gemm { const bf16_t* A; const bf16_t* Bt; int M, N, K; };

struct StaticOrder {
    int nM, nN, nwg, G, c;
    __host__ __device__ void init(int M, int N, int G_, int c_) { nM = M / BM; nN = N / BM; nwg = nM * nN; G = G_; c = c_; }
    __host__ __device__ bool next(int i, Unit& u) const {
        const long L = (long)i * G + c; if (L >= nwg) return false;
        int wgid = (int)L; { const int q = nwg / NXCD, r = nwg % NXCD, xcd = wgid % NXCD, off = wgid / NXCD; wgid = (xcd < r ? xcd * (q + 1) : r * (q + 1) + (xcd - r) * q) + off; }
        const int nig = WGM * nN, gid = wgid / nig, fm = gid * WGM, gsz = (nM - fm) < WGM ? (nM - fm) : WGM;
        u.pm = fm + ((wgid % nig) % gsz); u.pn = (wgid % nig) / gsz; return true;
    }
    __device__ __forceinline__ void a_ready(const Unit&) const {}
    __device__ __forceinline__ void done(const Unit&) const {}
};
__device__ __forceinline__ unsigned cvt_pk_bf16(float lo, float hi) { unsigned r; asm volatile("v_cvt_pk_bf16_f32 %0, %1, %2" : "=v"(r) : "v"(lo), "v"(hi)); return r; }
template <class Epi, class Sched, bool ALIGN_EPI = false, bool SP2 = false>
__device__ __forceinline__ void gemm_phase(PG8_LAS unsigned char* lds, const Gemm g, const Sched& S, const Epi& E) {
    int tid_o = threadIdx.x; asm volatile("" : "+v"(tid_o)); const int tid = tid_o, wid = __builtin_amdgcn_readfirstlane(tid >> 6), lane = tid & 63, wr = wid >> 2, wc = wid & 3, fr = lane & 15, fq = lane >> 4;
    const int K = g.K, nt = K / BK;
    unsigned voffA[2], voffB[2];
#pragma unroll
    for (int i = 0; i < 2; ++i) { int R, C; stage_rc(tid * 16 + i * 8192, R, C); const int Rb = Epi::PERM ? ((R & ~31) + perm32(R & 31)) : R;
        voffA[i] = (unsigned)(R * K + C) * 2u; voffB[i] = (unsigned)(Rb * K + C) * 2u; }
    const size_t kstep = (size_t)(BK * 2);
    const size_t hstep = (size_t)HALF * K * 2;
    const size_t tstep = 2 * hstep;
    const unsigned ldsw = (unsigned)wid * 1024u;
    const int aoff = lds_byte(wr * 64 + fr, fq * 8), boff = lds_byte(wc * 32 + fr, fq * 8);
#define PG8_SA(b, h) (((b) * 2 + (h)) * HTB)
#define PG8_SB(b, h) ((4 + (b) * 2 + (h)) * HTB)
#define PG8_STAGE(bufoff, gbase, voff) do { _Pragma("unroll") for (int _i = 0; _i < 2; ++_i) \
        __builtin_amdgcn_global_load_lds((const unsigned*)((const char*)(gbase) + (voff)[_i]), (PG8_LAS unsigned*)(lds + (bufoff) + ldsw + _i * 8192), 16, 0, 0); } while (0)
#define PG8_LDA(dst, b, h) do { _Pragma("unroll") for (int m = 0; m < 4; ++m) _Pragma("unroll") for (int k = 0; k < 2; ++k) dst[m][k] = *(const PG8_LAS bf16x8*)(lds + PG8_SA(b, h) + aoff + m * 2048 + k * 1024); } while (0)
#define PG8_LDB(dst, b, h) do { _Pragma("unroll") for (int n = 0; n < 2; ++n) _Pragma("unroll") for (int k = 0; k < 2; ++k) dst[n][k] = *(const PG8_LAS bf16x8*)(lds + PG8_SB(b, h) + boff + n * 2048 + k * 1024); } while (0)
#define PG8_MMA(ai, bj, At, Bt) do { __builtin_amdgcn_s_setprio(1); _Pragma("unroll") for (int m = 0; m < 4; ++m) _Pragma("unroll") for (int n = 0; n < 2; ++n) _Pragma("unroll") for (int k = 0; k < 2; ++k) \
        acc[ai][bj][m][n] = __builtin_amdgcn_mfma_f32_16x16x32_bf16(Bt[n][k], At[m][k], acc[ai][bj][m][n], 0, 0, 0); __builtin_amdgcn_s_setprio(0); } while (0)
#define PG8_WAIT_V(n) asm volatile("s_waitcnt vmcnt(" #n ")" ::: "memory")
#define PG8_WAIT_L(n) asm volatile("s_waitcnt lgkmcnt(" #n ")" ::: "memory")
#define PG8_BAR __builtin_amdgcn_s_barrier()
#define PG8_SCHED __builtin_amdgcn_sched_barrier(0)
    Unit cur, nxt; int ui = 0;
    if (!S.next(0, cur)) return;
    f32x4 acc[2][2][4][2];
#pragma unroll
    for (int a = 0; a < 2; ++a)
#pragma unroll
        for (int b = 0; b < 2; ++b)
#pragma unroll
            for (int m = 0; m < 4; ++m)
#pragma unroll
                for (int n = 0; n < 2; ++n) acc[a][b][m][n] = (f32x4){0.f, 0.f, 0.f, 0.f};
    bf16x8 At[4][2], B0[2][2], B1[2][2];
    const char* cA = (const char*)g.A + (size_t)cur.pm * tstep; const char* cB = (const char*)g.Bt + (size_t)cur.pn * tstep;
    S.a_ready(cur);
    if constexpr (SP2) {
        PG8_STAGE(PG8_SB(0, 0), cB, voffB); PG8_STAGE(PG8_SB(0, 1), cB + hstep, voffB); PG8_STAGE(PG8_SA(0, 0), cA, voffA); PG8_STAGE(PG8_SA(0, 1), cA + hstep, voffA);
        if (wr == 1) PG8_BAR;
        PG8_WAIT_V(2); PG8_BAR;
        PG8_STAGE(PG8_SB(1, 0), cB + kstep, voffB); PG8_STAGE(PG8_SA(1, 0), cA + kstep, voffA); PG8_STAGE(PG8_SB(1, 1), cB + hstep + kstep, voffB);
        PG8_WAIT_V(6); PG8_BAR;
    } else {
        PG8_STAGE(PG8_SB(0, 0), cB, voffB); PG8_STAGE(PG8_SA(0, 0), cA, voffA); PG8_STAGE(PG8_SB(0, 1), cB + hstep, voffB); PG8_STAGE(PG8_SA(0, 1), cA + hstep, voffA);
        if (wr == 1) PG8_BAR;
        PG8_WAIT_V(4); PG8_BAR;
        PG8_STAGE(PG8_SB(1, 0), cB + kstep, voffB); PG8_STAGE(PG8_SA(1, 0), cA + kstep, voffA); PG8_STAGE(PG8_SB(1, 1), cB + hstep + kstep, voffB);
        PG8_WAIT_V(6); PG8_BAR;
    }
    for (;;) {
        const bool has_next = S.next(ui + 1, nxt);
        const char* nA = has_next ? (const char*)g.A + (size_t)nxt.pm * tstep : cA; const char* nB = has_next ? (const char*)g.Bt + (size_t)nxt.pn * tstep : cB;
        for (int t = 0; t < nt; t += 2) {
            const bool last = (t == nt - 2);
            const char* a1 = cA + (size_t)(t + 1) * kstep;
            const char* a2 = last ? nA : cA + (size_t)(t + 2) * kstep; const char* b2 = last ? nB : cB + (size_t)(t + 2) * kstep;
            const char* a3 = a2 + kstep; const char* b3 = b2 + kstep;
            if (last && has_next) S.a_ready(nxt);
            if constexpr (SP2) {
            PG8_LDB(B0, 0, 0); PG8_LDB(B1, 0, 1); PG8_SCHED; PG8_LDA(At, 0, 0); PG8_STAGE(PG8_SA(1, 1), a1 + hstep, voffA);
            PG8_WAIT_V(8); PG8_WAIT_L(0); PG8_BAR; PG8_MMA(0, 0, At, B0); PG8_MMA(0, 1, At, B1); PG8_BAR; PG8_SCHED;
            PG8_LDA(At, 0, 1); PG8_STAGE(PG8_SB(0, 0), b2, voffB); PG8_STAGE(PG8_SB(0, 1), b2 + hstep, voffB); PG8_STAGE(PG8_SA(0, 0), a2, voffA);
            PG8_WAIT_V(8); PG8_WAIT_L(0); PG8_BAR; PG8_MMA(1, 0, At, B0); PG8_MMA(1, 1, At, B1); PG8_BAR; PG8_SCHED;
            PG8_LDB(B0, 1, 0); PG8_LDB(B1, 1, 1); PG8_SCHED; PG8_LDA(At, 1, 0); PG8_STAGE(PG8_SA(0, 1), a2 + hstep, voffA);
            PG8_WAIT_V(8); PG8_WAIT_L(0); PG8_BAR; PG8_MMA(0, 0, At, B0); PG8_MMA(0, 1, At, B1); PG8_BAR; PG8_SCHED;
            PG8_LDA(At, 1, 1); PG8_STAGE(PG8_SB(1, 0), b3, voffB); PG8_STAGE(PG8_SB(1, 1), b3 + hstep, voffB); PG8_STAGE(PG8_SA(1, 0), a3, voffA);
            PG8_WAIT_V(8); PG8_WAIT_L(0); PG8_BAR; PG8_MMA(1, 0, At, B0); PG8_MMA(1, 1, At, B1); PG8_BAR; PG8_SCHED;
            } else {
            PG8_LDB(B0, 0, 0); PG8_SCHED; PG8_LDA(At, 0, 0); PG8_STAGE(PG8_SA(1, 1), a1 + hstep, voffA);
            PG8_WAIT_L(8); PG8_BAR; PG8_WAIT_L(0); PG8_MMA(0, 0, At, B0); PG8_BAR; PG8_SCHED;
            PG8_LDB(B1, 0, 1); PG8_STAGE(PG8_SB(0, 0), b2, voffB);
            PG8_BAR; PG8_WAIT_L(0); PG8_MMA(0, 1, At, B1); PG8_BAR;
            PG8_LDA(At, 0, 1); PG8_STAGE(PG8_SA(0, 0), a2, voffA);
            PG8_BAR; PG8_WAIT_L(0); PG8_MMA(1, 0, At, B0); PG8_BAR; PG8_SCHED;
            PG8_STAGE(PG8_SB(0, 1), b2 + hstep, voffB);
            PG8_WAIT_V(6); PG8_BAR; PG8_MMA(1, 1, At, B1); PG8_BAR;
            PG8_LDB(B0, 1, 0); PG8_SCHED; PG8_LDA(At, 1, 0); PG8_STAGE(PG8_SA(0, 1), a2 + hstep, voffA);
            PG8_WAIT_L(8); PG8_BAR; PG8_WAIT_L(0); PG8_MMA(0, 0, At, B0); PG8_BAR; PG8_SCHED;
            PG8_LDB(B1, 1, 1); PG8_STAGE(PG8_SB(1, 0), b3, voffB);
            PG8_BAR; PG8_WAIT_L(0); PG8_MMA(0, 1, At, B1); PG8_BAR;
            PG8_LDA(At, 1, 1); PG8_STAGE(PG8_SA(1, 0), a3, voffA);
            PG8_BAR; PG8_WAIT_L(0); PG8_MMA(1, 0, At, B0); PG8_BAR; PG8_SCHED;
            PG8_STAGE(PG8_SB(1, 1), b3 + hstep, voffB);
            PG8_WAIT_V(6); PG8_BAR; PG8_MMA(1, 1, At, B1); PG8_BAR;
            }
        }
        if constexpr (ALIGN_EPI) { if (wr == 0) PG8_BAR; }
        if constexpr (!Epi::AFTER_DRAIN) { E(acc, cur, wr, wc, fr, fq); S.done(cur); }
        if (!has_next) break;
#pragma unroll
        for (int a = 0; a < 2; ++a)
#pragma unroll
            for (int b = 0; b < 2; ++b)
#pragma unroll
                for (int m = 0; m < 4; ++m)
#pragma unroll
                    for (int n = 0; n < 2; ++n) acc[a][b][m][n] = (f32x4){0.f, 0.f, 0.f, 0.f};
        cur = nxt; cA = nA; cB = nB; ++ui;
        if constexpr (ALIGN_EPI) { if (wr == 1) PG8_BAR; }
    }
    PG8_WAIT_V(0);
    if constexpr (!ALIGN_EPI) { if (wr == 0) PG8_BAR; }
    PG8_BAR;
    if constexpr (Epi::AFTER_DRAIN) { E.fused(acc, cur, wr, wc, fr, fq, lds, wid, lane); S.done(cur); }
#undef PG8_SA
#undef PG8_SB
#undef PG8_STAGE
#undef PG8_LDA
#undef PG8_LDB
#undef PG8_MMA
#undef PG8_WAIT_V
#undef PG8_WAIT_L
#undef PG8_BAR
#undef PG8_SCHED
}
}

#define LAS __attribute__((address_space(3)))
typedef unsigned short bf16_t;
typedef short bf16x8 __attribute__((ext_vector_type(8)));
typedef float f32x4 __attribute__((ext_vector_type(4)));
typedef float f32x2 __attribute__((ext_vector_type(2)));
typedef unsigned u32x4 __attribute__((ext_vector_type(4)));
typedef unsigned u32x2 __attribute__((ext_vector_type(2)));

constexpr int D = 1024, DFF = 2816, NIN = 2560, T = 12288, TCTX = 8192;
constexpr int NMOD = 9216;
constexpr float ALPHA = 1.41421356237309515f;
constexpr float QSCALE = 0.125f * 1.44269504088896341f;
constexpr int NTHREADS = 512, NWAVES = 8;
constexpr int LDS_BYTES = 147456;
#ifndef EN_MASK
#define EN_MASK 0xFFFF
#endif
#ifndef REP_MASK
#define REP_MASK 0
#endif

constexpr size_t MiB = 1u << 20;
constexpr size_t WS_CTL = 0, CTL_BYTES = 65536;
constexpr size_t WS_MOD = 65536;
constexpr size_t WS_ROPE = 524288;
constexpr size_t WS_W = 2 * MiB, W_LAYER = 40 * MiB;
constexpr size_t W_1IN = 0, W_1OUT = 11 * MiB, W_2IN = 16 * MiB + MiB / 2, W_2OUT = 27 * MiB + MiB / 2, W_IN = 33 * MiB, W_OUT = 38 * MiB;
constexpr size_t WS_X = 82 * MiB;
constexpr size_t WS_A = 130 * MiB;
constexpr size_t WS_HZ = 154 * MiB;
constexpr size_t WS_Q = 220 * MiB;
constexpr size_t WS_K = 232 * MiB, WS_V = 236 * MiB;
constexpr size_t WS_OH = 240 * MiB;
constexpr size_t WS_END = 264 * MiB;
constexpr int KV_LAT_OFF = 32 * 2 * 256 * 64;
constexpr size_t OUT_Y = 0, OUT_CK = (size_t)T * D, OUT_CV = OUT_CK + 2097152, OUT_ST = OUT_CV + 2097152;

struct Params { const float* in[25]; float* out; unsigned char* ws; };

__device__ __forceinline__ unsigned cvt_pk(float lo, float hi) { unsigned r; asm("v_cvt_pk_bf16_f32 %0, %1, %2" : "=v"(r) : "v"(lo), "v"(hi)); return r; }
typedef __bf16 bf16x2_t __attribute__((ext_vector_type(2)));
__device__ __forceinline__ unsigned cvt_pk_b(float lo, float hi) { f32x2 v = {lo, hi}; bf16x2_t b = __builtin_convertvector(v, bf16x2_t); return __builtin_bit_cast(unsigned, b); }
__device__ __forceinline__ unsigned cvt_pk_c(float lo, float hi) { unsigned r; asm volatile("v_cvt_pk_bf16_f32 %0, %1, %2\n\ts_nop 1" : "=v"(r) : "v"(lo), "v"(hi)); return r; }
__device__ __forceinline__ float bf_lo(unsigned u) { return __uint_as_float(u << 16); }
__device__ __forceinline__ float bf_hi(unsigned u) { return __uint_as_float(u & 0xffff0000u); }
__device__ __forceinline__ float silu_f(float x) { return x / (1.0f + __expf(-x)); }
__device__ __forceinline__ float sigmoid_f(float x) { return 1.0f / (1.0f + __expf(-x)); }
__device__ __forceinline__ float wave_sum(float v) {
#pragma unroll
    for (int o = 1; o < 64; o <<= 1) v += __shfl_xor(v, o);
    return v;
}
__device__ __forceinline__ int otid() { int t = threadIdx.x; asm volatile("" : "+v"(t)); return t; }
__device__ __forceinline__ int cond_of_row(int row) { return row < TCTX ? 0 : 1 + ((row - TCTX) >> 11); }

struct EpiSwiglu {
    static constexpr bool PERM = true, AFTER_DRAIN = false;
    bf16_t* H;
    __device__ __forceinline__ void operator()(const pg8::f32x4 (&acc)[2][2][4][2], const pg8::Unit& u, int wr, int wc, int fr, int fq) const {
        const int row0 = u.pm * 256 + wr * 64 + fr, col0 = u.pn * 128 + wc * 32 + 8 * fq;
#pragma unroll
        for (int ai = 0; ai < 2; ++ai)
#pragma unroll
            for (int m = 0; m < 4; ++m) {
                bf16_t* rowp = H + (size_t)(row0 + ai * 128 + m * 16) * DFF + col0;
                float h[8];
#pragma unroll
                for (int n = 0; n < 2; ++n)
#pragma unroll
                    for (int i = 0; i < 4; ++i) { const float g = acc[ai][0][m][n][i], up = acc[ai][1][m][n][i]; h[n * 4 + i] = silu_f(g) * up; }
                u32x4 w; w.x = cvt_pk(h[0], h[1]); w.y = cvt_pk(h[2], h[3]); w.z = cvt_pk(h[4], h[5]); w.w = cvt_pk(h[6], h[7]);
                *(u32x4*)rowp = w;
            }
    }
};
struct EpiZ {
    static constexpr bool PERM = true, AFTER_DRAIN = false;
    bf16_t* O; int ldc;
    __device__ __forceinline__ void operator()(const pg8::f32x4 (&acc)[2][2][4][2], const pg8::Unit& u, int wr, int wc, int fr, int fq) const {
        const int row0 = u.pm * 256 + wr * 64 + fr, col0 = u.pn * 256 + wc * 32 + 8 * fq;
#pragma unroll
        for (int ai = 0; ai < 2; ++ai)
#pragma unroll
            for (int m = 0; m < 4; ++m) {
                bf16_t* rowp = O + (size_t)(row0 + ai * 128 + m * 16) * ldc + col0;
#pragma unroll
                for (int bj = 0; bj < 2; ++bj) {
                    const pg8::f32x4 v0 = acc[ai][bj][m][0], v1 = acc[ai][bj][m][1];
                    u32x4 w; w.x = cvt_pk(v0[0], v0[1]); w.y = cvt_pk(v0[2], v0[3]); w.z = cvt_pk(v1[0], v1[1]); w.w = cvt_pk(v1[2], v1[3]);
                    *(u32x4*)(rowp + bj * 128) = w;
                }
            }
    }
};
struct EpiResid {
    static constexpr bool PERM = false, AFTER_DRAIN = false;
    float* X; const float* gate; float s;
    __device__ __forceinline__ void operator()(const pg8::f32x4 (&acc)[2][2][4][2], const pg8::Unit& u, int wr, int wc, int fr, int fq) const {
        const int cond = u.pm < 32 ? 0 : 1 + ((u.pm - 32) >> 3);
        const float* gv = gate + cond * NMOD;
        const int row0 = u.pm * 256 + wr * 64 + fr, col0 = u.pn * 256 + wc * 32 + 4 * fq;
#pragma unroll
        for (int bj = 0; bj < 2; ++bj)
#pragma unroll
            for (int n = 0; n < 2; ++n) {
                const int c = col0 + bj * 128 + n * 16;
                const f32x4 g = *(const f32x4*)(gv + c) * s;
#pragma unroll
                for (int ai = 0; ai < 2; ++ai)
#pragma unroll
                    for (int m = 0; m < 4; ++m) {
                        f32x4* px = (f32x4*)(X + (size_t)(row0 + ai * 128 + m * 16) * D + c);
                        const f32x4 xv = *px;
                        *px = xv * ALPHA + g * acc[ai][bj][m][n];
                    }
            }
    }
};

__device__ __forceinline__ void transpose_item(const float* W, int K, int N, bf16_t* WT, int k0, int n0, int dst_row0, LAS float* scr, int lane) {
#pragma unroll 8
    for (int i = 0; i < 32; ++i) { const int kk = 2 * i + (lane >> 5); scr[kk * 33 + (lane & 31)] = W[(size_t)(k0 + kk) * N + n0 + (lane & 31)]; }
    asm volatile("s_waitcnt lgkmcnt(0)" ::: "memory");
    const int c = lane & 7;
#pragma unroll
    for (int j = 0; j < 4; ++j) {
        const int n = (lane >> 3) + 8 * j; const LAS float* s = scr + (8 * c) * 33 + n;
        u32x4 o; o.x = cvt_pk(s[0 * 33], s[1 * 33]); o.y = cvt_pk(s[2 * 33], s[3 * 33]); o.z = cvt_pk(s[4 * 33], s[5 * 33]); o.w = cvt_pk(s[6 * 33], s[7 * 33]);
        *(u32x4*)(WT + (size_t)(dst_row0 + n) * K + k0 + 8 * c) = o;
    }
    asm volatile("s_waitcnt lgkmcnt(0)" ::: "memory");
}
__device__ __forceinline__ int swiglu_row(int n) { return n < DFF ? (n >> 7) * 256 + (n & 127) : ((n - DFF) >> 7) * 256 + 128 + ((n - DFF) & 127); }

__device__ __forceinline__ void mod_item(const Params& p, int it, LAS unsigned char* lds) {
    const int tid = otid();
    LAS float* sl = (LAS float*)lds;
    LAS float* red = sl + 3072;
    const int l = it / 72, cg0 = (it % 72) * 128;
    for (int i = tid; i < 3072; i += NTHREADS) { const int c = i >> 10, k = i & 1023; const float v = c == 0 ? p.in[6][k] : p.in[5][(c - 1) * 1024 + k]; sl[i] = silu_f(v); }
    __syncthreads();
    const int cq = tid & 31, ks = tid >> 5;
    const float* w = p.in[7] + ((size_t)l * 1024 + ks * 64) * NMOD + cg0 + cq * 4;
    f32x4 a0 = {0.f, 0.f, 0.f, 0.f}, a1 = a0, a2 = a0;
#pragma unroll 8
    for (int k = 0; k < 64; ++k) {
        const f32x4 wv = *(const f32x4*)(w + (size_t)k * NMOD); const int kk = ks * 64 + k;
        a0 += wv * sl[kk]; a1 += wv * sl[1024 + kk]; a2 += wv * sl[2048 + kk];
    }
    *(LAS f32x4*)(red + (ks * 3 + 0) * 128 + cq * 4) = a0;
    *(LAS f32x4*)(red + (ks * 3 + 1) * 128 + cq * 4) = a1;
    *(LAS f32x4*)(red + (ks * 3 + 2) * 128 + cq * 4) = a2;
    __syncthreads();
    if (tid < 384) {
        const int c = tid >> 7, col = tid & 127; float s = 0.f;
#pragma unroll
        for (int k = 0; k < 16; ++k) s += red[(k * 3 + c) * 128 + col];
        ((float*)(p.ws + WS_MOD))[(size_t)(l * 3 + c) * NMOD + cg0 + col] = s + p.in[8][(size_t)l * NMOD + cg0 + col];
    }
    __syncthreads();
}

__device__ __forceinline__ void prologue(const Params& p, LAS unsigned char* lds) {
    const int tid = otid(), lane = tid & 63, wave = tid >> 6;
    const int G = gridDim.x;
    for (int it = blockIdx.x; it < 144; it += G) mod_item(p, it, lds);
    if (blockIdx.x == G - 1) {
        float* rc = (float*)(p.ws + WS_ROPE);
        for (int i = tid; i < 1024; i += NTHREADS) {
            const int pos = i >> 4, pp = i & 15;
            const float inv = exp2f(-(float)pp * (13.287712379549449f / 16.0f));
            const float ang = (float)pos * inv;
            rc[i] = cosf(ang); rc[1024 + i] = sinf(ang);
        }
    }
    __syncthreads();
    LAS float* scr = (LAS float*)(lds + wave * 16384);
    const int gw = blockIdx.x * NWAVES + wave, NGW = G * NWAVES;
    for (int it = gw; it < 20480; it += NGW) {
        const int l = it / 10240; int r = it % 10240;
        bf16_t* wl = (bf16_t*)(p.ws + WS_W + (size_t)l * W_LAYER);
        if (r < 5632) {
            const int which = r / 2816; r %= 2816;
            const int kb = r / 176, nb = r % 176;
            const float* W = p.in[which ? 13 : 11] + (size_t)l * 1024 * 5632;
            transpose_item(W, 1024, 5632, (bf16_t*)((unsigned char*)wl + (which ? W_2IN : W_1IN)), kb * 64, nb * 32, swiglu_row(nb * 32), scr, lane);
        } else if (r < 5632 + 2816) {
            r -= 5632; const int which = r / 1408; r %= 1408;
            const int kb = r / 32, nb = r % 32;
            const float* W = p.in[which ? 14 : 12] + (size_t)l * 2816 * 1024;
            transpose_item(W, 2816, 1024, (bf16_t*)((unsigned char*)wl + (which ? W_2OUT : W_1OUT)), kb * 64, nb * 32, nb * 32, scr, lane);
        } else if (r < 5632 + 2816 + 1280) {
            r -= 5632 + 2816; const int kb = r / 80, nb = r % 80;
            transpose_item(p.in[15] + (size_t)l * 1024 * 2560, 1024, 2560, (bf16_t*)((unsigned char*)wl + W_IN), kb * 64, nb * 32, nb * 32, scr, lane);
        } else {
            r -= 5632 + 2816 + 1280; const int kb = r / 32, nb = r % 32;
            transpose_item(p.in[16] + (size_t)l * 1024 * 1024, 1024, 1024, (bf16_t*)((unsigned char*)wl + W_OUT), kb * 64, nb * 32, nb * 32, scr, lane);
        }
    }
}

__device__ __forceinline__ void store_mod_row(bf16_t* arow, const f32x4 (&x)[4], const float* sh, const float* sc, int lane) {
#pragma unroll
    for (int j = 0; j < 4; ++j) {
        const int c = 4 * lane + 256 * j;
        const f32x4 s = *(const f32x4*)(sh + c), k = *(const f32x4*)(sc + c);
        const f32x4 a = x[j] * (k + 1.0f) + s;
        u32x2 w; w.x = cvt_pk(a[0], a[1]); w.y = cvt_pk(a[2], a[3]);
        *(u32x2*)(arow + c) = w;
    }
}
__device__ __forceinline__ void init_rows(const Params& p) {
    const int tid_ = otid(); const int lane = tid_ & 63, wave = tid_ >> 6;
    const int gw = blockIdx.x * NWAVES + wave, NGW = gridDim.x * NWAVES;
    float* X = (float*)(p.ws + WS_X); bf16_t* A = (bf16_t*)(p.ws + WS_A); const float* MOD = (const float*)(p.ws + WS_MOD);
    for (int row = gw; row < T; row += NGW) {
        const float* src = row < TCTX ? p.in[0] + (size_t)row * D : p.in[1] + (size_t)(row - TCTX) * D;
        const int cond = cond_of_row(row);
        f32x4 v[4];
#pragma unroll
        for (int j = 0; j < 4; ++j) { v[j] = *(const f32x4*)(src + 4 * lane + 256 * j); *(f32x4*)(X + (size_t)row * D + 4 * lane + 256 * j) = v[j]; }
        store_mod_row(A + (size_t)row * D, v, MOD + cond * NMOD + 0 * 1024, MOD + cond * NMOD + 1 * 1024, lane);
    }
}
__device__ __forceinline__ void ln_rows(const Params& p, const float* g, const float* b, const float* modn, int shi, float* final_out) {
    const int tid_ = otid(); const int lane = tid_ & 63, wave = tid_ >> 6;
    const int gw = blockIdx.x * NWAVES + wave, NGW = gridDim.x * NWAVES;
    float* X = (float*)(p.ws + WS_X); bf16_t* A = (bf16_t*)(p.ws + WS_A);
    for (int row = gw; row < T; row += NGW) {
        f32x4 v[4]; float s = 0.f;
#pragma unroll
        for (int j = 0; j < 4; ++j) { v[j] = *(const f32x4*)(X + (size_t)row * D + 4 * lane + 256 * j); s += (v[j][0] + v[j][1]) + (v[j][2] + v[j][3]); }
        const float mean = wave_sum(s) * (1.0f / D); float q = 0.f;
#pragma unroll
        for (int j = 0; j < 4; ++j) { v[j] = v[j] - mean; q += (v[j][0] * v[j][0] + v[j][1] * v[j][1]) + (v[j][2] * v[j][2] + v[j][3] * v[j][3]); }
        const float rstd = 1.0f / sqrtf(wave_sum(q) * (1.0f / D) + 1e-5f);
        float* dst = final_out ? final_out + (size_t)row * D : X + (size_t)row * D;
#pragma unroll
        for (int j = 0; j < 4; ++j) {
            const int c = 4 * lane + 256 * j;
            v[j] = v[j] * rstd * *(const f32x4*)(g + c) + *(const f32x4*)(b + c);
            *(f32x4*)(dst + c) = v[j];
        }
        if (!final_out) { const int cond = cond_of_row(row); store_mod_row(A + (size_t)row * D, v, modn + cond * NMOD + shi * 1024, modn + cond * NMOD + (shi + 1) * 1024, lane); }
    }
}

#ifndef STATIC_Q
#define STATIC_Q 1
#endif
__device__ __forceinline__ int next_item(unsigned* ctr, LAS int* slot, int& k, int nlong = 0) {
    __syncthreads();
#if STATIC_Q
    if (nlong > 0 && (int)gridDim.x > nlong) {
        if ((int)blockIdx.x < nlong) { const int r = k == 0 ? (int)blockIdx.x : 0x7fffffff; ++k; return r; }
        const int r = nlong + ((int)blockIdx.x - nlong) + k * ((int)gridDim.x - nlong); ++k; return r;
    }
    const int r = blockIdx.x + k * gridDim.x; ++k; return r;
#else
    if (threadIdx.x == 0) *slot = (int)atomicAdd(ctr, 1u);
    __syncthreads();
    return *slot;
#endif
}

__device__ __forceinline__ void prep_item(const Params& p, int l, int it) {
    const int tid_ = otid(); const int lane = tid_ & 63, wave = tid_ >> 6;
    const bf16_t* Z = (const bf16_t*)(p.ws + WS_HZ);
    bf16_t* Qb = (bf16_t*)(p.ws + WS_Q); bf16_t* Kb = (bf16_t*)(p.ws + WS_K); bf16_t* Vb = (bf16_t*)(p.ws + WS_V);
    const float* rc = (const float*)(p.ws + WS_ROPE);
    const int sb = lane & 7;
    float gq[8], gk[8];
#pragma unroll
    for (int i = 0; i < 8; ++i) { gq[i] = p.in[23][l * 64 + sb * 8 + i]; gk[i] = p.in[24][l * 64 + sb * 8 + i]; }
    for (int r8 = 0; r8 < 8; ++r8) {
        const int row = it * 64 + wave * 8 + r8;
        const bool lat = row >= TCTX;
        const int tl = lat ? ((row - TCTX) & 2047) : (row & 255);
        const int pos = (sb < 4) ? (tl >> 6) : (tl & 63);
        float cs[8], sn[8];
#pragma unroll
        for (int i = 0; i < 8; ++i) { cs[i] = rc[pos * 16 + (sb & 1) * 8 + i]; sn[i] = rc[1024 + pos * 16 + (sb & 1) * 8 + i]; }
        {
            const u32x4 z = *(const u32x4*)(Z + (size_t)row * NIN + 1792 + lane * 8);
            float x[8] = {bf_lo(z.x), bf_hi(z.x), bf_lo(z.y), bf_hi(z.y), bf_lo(z.z), bf_hi(z.z), bf_lo(z.w), bf_hi(z.w)};
            float ss = 0.f;
#pragma unroll
            for (int i = 0; i < 8; ++i) ss += x[i] * x[i];
            ss += __shfl_xor(ss, 1); ss += __shfl_xor(ss, 2); ss += __shfl_xor(ss, 4);
            const float rr = 1.0f / sqrtf(ss * (1.0f / 64.0f) + 1e-6f);
#pragma unroll
            for (int i = 0; i < 8; ++i) x[i] = x[i] * rr * gq[i];
#pragma unroll
            for (int i = 0; i < 8; ++i) {
                const float o = __shfl_xor(x[i], 2);
                const float r = (sb & 2) ? x[i] * cs[i] + o * sn[i] : x[i] * cs[i] - o * sn[i];
                x[i] = (lat ? r : x[i]) * QSCALE;
            }
            u32x4 w; w.x = cvt_pk(x[0], x[1]); w.y = cvt_pk(x[2], x[3]); w.z = cvt_pk(x[4], x[5]); w.w = cvt_pk(x[6], x[7]);
            *(u32x4*)(Qb + (size_t)row * 512 + lane * 8) = w;
        }
        {
            const int ln = lane & 31;
            const u32x4 z = *(const u32x4*)(Z + (size_t)row * NIN + 2304 + ln * 8);
            float x[8] = {bf_lo(z.x), bf_hi(z.x), bf_lo(z.y), bf_hi(z.y), bf_lo(z.z), bf_hi(z.z), bf_lo(z.w), bf_hi(z.w)};
            float ss = 0.f;
#pragma unroll
            for (int i = 0; i < 8; ++i) ss += x[i] * x[i];
            ss += __shfl_xor(ss, 1); ss += __shfl_xor(ss, 2); ss += __shfl_xor(ss, 4);
            const float rr = 1.0f / sqrtf(ss * (1.0f / 64.0f) + 1e-6f);
            const bool isk = ln < 16;
#pragma unroll
            for (int i = 0; i < 8; ++i) {
                const float xn = x[i] * rr * gk[i];
                const float o = __shfl_xor(xn, 2);
                const float r = (sb & 2) ? xn * cs[i] + o * sn[i] : xn * cs[i] - o * sn[i];
                x[i] = isk ? (lat ? r : xn) : x[i];
            }
            if (lane < 32) {
                const int kvh = (ln >> 3) & 1;
                bf16_t* dstb = isk ? Kb : Vb;
                size_t off;
                if (!lat) { const int s = row >> 8; off = ((size_t)(s * 2 + kvh) * 256 + tl) * 64 + sb * 8; }
                else { const int bb = (row - TCTX) >> 11; off = (size_t)KV_LAT_OFF + ((size_t)(bb * 2 + kvh) * 2560 + 512 + tl) * 64 + sb * 8; }
                u32x4 w; w.x = cvt_pk(x[0], x[1]); w.y = cvt_pk(x[2], x[3]); w.z = cvt_pk(x[4], x[5]); w.w = cvt_pk(x[6], x[7]);
                *(u32x4*)(dstb + off) = w;
                if (!lat) {
                    const int s = row >> 8;
                    float* o = p.out + (isk ? OUT_CK : OUT_CV) + ((((size_t)s * 2 + l) * 256 + tl) * 2 + kvh) * 64 + sb * 8;
                    *(f32x4*)o = (f32x4){x[0], x[1], x[2], x[3]}; *(f32x4*)(o + 4) = (f32x4){x[4], x[5], x[6], x[7]};
                }
            }
        }
    }
}
__device__ __forceinline__ void prepc_item(const Params& p, int l, int it) {
    const int tid_ = otid(); const int lane = tid_ & 63, wave = tid_ >> 6;
    bf16_t* Kb = (bf16_t*)(p.ws + WS_K); bf16_t* Vb = (bf16_t*)(p.ws + WS_V);
    for (int r = 0; r < 16; ++r) {
        const int bp = it * 128 + wave * 16 + r;
        const int bb = bp >> 9, pos = bp & 511;
        if (lane < 32) {
            const bool isk = lane < 16; const int ln = lane & 15, kvh = ln >> 3, sb = ln & 7;
            const float* src = (isk ? p.in[2] : p.in[3]) + ((((size_t)bb * 2 + l) * 512 + pos) * 2 + kvh) * 64 + sb * 8;
            const f32x4 a = *(const f32x4*)src, b = *(const f32x4*)(src + 4);
            u32x4 w; w.x = cvt_pk(a[0], a[1]); w.y = cvt_pk(a[2], a[3]); w.z = cvt_pk(b[0], b[1]); w.w = cvt_pk(b[2], b[3]);
            *(u32x4*)((isk ? Kb : Vb) + (size_t)KV_LAT_OFF + ((size_t)(bb * 2 + kvh) * 2560 + pos) * 64 + sb * 8) = w;
        }
    }
}

__device__ __forceinline__ void hgrn_item(const Params& p, int l, int L, int rowbase, int bidx, bool lat, int h, int dir, int eg, LAS unsigned char* lds) {
    const int tid = otid();
    LAS float* qs = (LAS float*)lds;
    LAS float* fs = qs + 4096;
    LAS float* ks = fs + 4096;
    LAS float* vs = ks + 4096;
    LAS float* part = vs + 1024;
    const bf16_t* Z = (const bf16_t*)(p.ws + WS_HZ);
    float* OH = (float*)(p.ws + WS_OH) + (size_t)dir * T * 256;
    const int ss = tid >> 4, sj = tid & 15;
    float lbv[4];
#pragma unroll
    for (int i = 0; i < 4; ++i) {
        const int dd = h * 64 + 4 * sj + i;
        lbv[i] = (l == 0) ? 0.f : 1.0f / (1.0f + __expf(p.in[17][dd] - p.in[17][256 + dd]));
    }
    const int cq = h * 64 + 4 * sj, cf = (dir ? 768 : 512) + h * 64 + 4 * sj, cv = 256 + h * 64 + eg * 16 + sj;
    const int el = tid & 15, dg = tid >> 4;
    float S0 = 0.f, S1 = 0.f;
    if (lat) {
        const float* s0 = p.in[4] + ((((size_t)bidx * 2 + l) * 2 + dir) * 4 + h) * 4096;
        S0 = s0[(2 * dg) * 64 + eg * 16 + el]; S1 = s0[(2 * dg + 1) * 64 + eg * 16 + el];
    }
    const int nb = L >> 5;
    u32x2 rq, rf; unsigned short rv;
#define HG_LOAD(bt) do { const int n_ = (bt) * 32 + ss; const int t_ = dir ? (L - 1 - n_) : n_; const bf16_t* zr_ = Z + (size_t)(rowbase + t_) * NIN; \
        rq = *(const u32x2*)(zr_ + cq); rf = *(const u32x2*)(zr_ + cf); rv = zr_[cv]; } while (0)
#define HG_STAGE(buf) do { const float zq_[4] = {bf_lo(rq.x), bf_hi(rq.x), bf_lo(rq.y), bf_hi(rq.y)}; const float zf_[4] = {bf_lo(rf.x), bf_hi(rf.x), bf_lo(rf.y), bf_hi(rf.y)}; \
        f32x4 fq_, ff_, fk_; _Pragma("unroll") for (int i = 0; i < 4; ++i) { const float f_ = lbv[i] + (1.0f - lbv[i]) * sigmoid_f(zf_[i]); fq_[i] = zq_[i]; ff_[i] = fmaxf(f_, 1e-6f); fk_[i] = 1.0f - f_; } \
        *(LAS f32x4*)(qs + (buf) * 2048 + ss * 64 + 4 * sj) = fq_; *(LAS f32x4*)(fs + (buf) * 2048 + ss * 64 + 4 * sj) = ff_; *(LAS f32x4*)(ks + (buf) * 2048 + ss * 64 + 4 * sj) = fk_; \
        vs[(buf) * 512 + ss * 16 + sj] = __uint_as_float((unsigned)rv << 16); } while (0)
    HG_LOAD(0);
    HG_STAGE(0);
    __syncthreads();
    for (int bt = 0; bt < nb; ++bt) {
        const int cur = bt & 1;
        if (bt + 1 < nb) HG_LOAD(bt + 1);
        const LAS float* q_ = qs + cur * 2048 + 2 * dg; const LAS float* f_ = fs + cur * 2048 + 2 * dg; const LAS float* k_ = ks + cur * 2048 + 2 * dg;
        const LAS float* v_ = vs + cur * 512 + el;
#pragma unroll 8
        for (int s = 0; s < 32; ++s) {
            const f32x2 f2 = *(const LAS f32x2*)(f_ + s * 64), k2 = *(const LAS f32x2*)(k_ + s * 64), q2 = *(const LAS f32x2*)(q_ + s * 64);
            const float v = v_[s * 16];
            S0 = f2[0] * S0 + k2[0] * v; S1 = f2[1] * S1 + k2[1] * v;
            part[s * 528 + tid] = q2[0] * S0 + q2[1] * S1;
        }
        __syncthreads();
        {
            float o = 0.f;
#pragma unroll
            for (int g = 0; g < 32; ++g) o += part[ss * 528 + g * 16 + sj];
            const int n = bt * 32 + ss; const int t = dir ? (L - 1 - n) : n;
            OH[(size_t)(rowbase + t) * 256 + h * 64 + eg * 16 + sj] = o;
        }
        if (bt + 1 < nb) HG_STAGE(cur ^ 1);
        __syncthreads();
    }
#undef HG_LOAD
#undef HG_STAGE
    if (!lat) {
        float* sf = p.out + OUT_ST + ((((size_t)bidx * 2 + l) * 2 + dir) * 4 + h) * 4096;
        sf[(2 * dg) * 64 + eg * 16 + el] = S0; sf[(2 * dg + 1) * 64 + eg * 16 + el] = S1;
    }
}


__device__ __forceinline__ int hg_tt(int r, int u) { return r * 64 + ((u ^ ((r >> 2) & 3)) << 3); }
__device__ __forceinline__ int hg_gs(int e, int u) { return e * 128 + ((u ^ (e & 7)) << 4); }
__device__ __forceinline__ void hgrn_chain(const Params& p, int l, int L, int rowbase, int bidx, bool lat, int h, int dir, LAS unsigned char* lds) {
    const int tid = otid(), lane = tid & 63, wave = tid >> 6;
    const int qr = lane & 15, kq = lane >> 4;
    LAS unsigned char* wb = lds + wave * 17408;
    LAS unsigned char* QT = wb; LAS unsigned char* KT = wb + 4608; LAS unsigned char* KTT = wb + 9216; LAS unsigned char* VT = wb + 13312; LAS unsigned char* GS = wb + 9216;
    LAS float* vec = (LAS float*)(lds + 8 * 17408) + wave * 192;
    const bf16_t* Z = (const bf16_t*)(p.ws + WS_HZ);
    float* OH = (float*)(p.ws + WS_OH) + (size_t)dir * T * 256;
    const int cq = h * 64, cf = (dir ? 768 : 512) + h * 64, cv = 256 + h * 64;
    const float lb = (l == 0) ? 0.f : 1.0f / (1.0f + __expf(p.in[17][h * 64 + lane] - p.in[17][256 + h * 64 + lane]));
    const int e2 = tid >> 3, u2 = tid & 7;
    float S[8];
#pragma unroll
    for (int j = 0; j < 8; ++j) S[j] = 0.f;
    if (lat) {
        const float* s0 = p.in[4] + ((((size_t)bidx * 2 + l) * 2 + dir) * 4 + h) * 4096;
#pragma unroll
        for (int j = 0; j < 8; ++j) S[j] = s0[(8 * u2 + j) * 64 + e2];
    }
    const int nround = L >> 8;
    for (int r = 0; r < nround; ++r) {
        const int n0 = (r * 8 + wave) * 32;
        const int trow0 = dir ? (L - 1 - n0) : n0, tstep = dir ? -1 : 1;
        const bf16_t* zb = Z + (size_t)(rowbase + trow0) * NIN + lane;
        const long zs = (long)tstep * NIN;
        unsigned short rzf[32], rzq[32], rzv[32];
#pragma unroll
        for (int t = 0; t < 32; ++t) rzf[t] = zb[t * zs + cf];
#pragma unroll
        for (int t = 0; t < 32; ++t) rzq[t] = zb[t * zs + cq];
#pragma unroll
        for (int t = 0; t < 32; ++t) rzv[t] = zb[t * zs + cv];
        {
            float a[32], kk[32]; float run = 0.f;
#pragma unroll
            for (int t = 0; t < 32; ++t) {
                const float zf = __uint_as_float((unsigned)rzf[t] << 16);
                const float f = lb + (1.0f - lb) * sigmoid_f(zf);
                run += __logf(fmaxf(f, 1e-6f)); a[t] = run; kk[t] = 1.0f - f;
            }
            const float aref = a[15], alast = a[31];
            vec[lane] = __expf(alast); vec[64 + lane] = __expf(aref); vec[128 + lane] = __expf(alast - aref);
            unsigned kp[16];
#pragma unroll
            for (int t = 0; t < 32; t += 2) {
                const float x0 = fminf(fmaxf(a[t] - aref, -60.f), 60.f), x1 = fminf(fmaxf(a[t + 1] - aref, -60.f), 60.f);
                const float w0 = __expf(x0), w1 = __expf(x1), i0 = __expf(-x0), i1 = __expf(-x1);
                const float q0 = __uint_as_float((unsigned)rzq[t] << 16), q1 = __uint_as_float((unsigned)rzq[t + 1] << 16);
                const unsigned qp = cvt_pk(q0 * w0, q1 * w1), kpk = cvt_pk(kk[t] * i0, kk[t + 1] * i1);
                *(LAS unsigned short*)(QT + t * 144 + lane * 2) = (unsigned short)(qp & 0xffffu);
                *(LAS unsigned short*)(QT + (t + 1) * 144 + lane * 2) = (unsigned short)(qp >> 16);
                *(LAS unsigned short*)(KT + t * 144 + lane * 2) = (unsigned short)(kpk & 0xffffu);
                *(LAS unsigned short*)(KT + (t + 1) * 144 + lane * 2) = (unsigned short)(kpk >> 16);
                kp[t >> 1] = kpk;
            }
#pragma unroll
            for (int u = 0; u < 8; ++u) *(LAS u32x2*)(KTT + hg_tt(lane, u)) = (u32x2){kp[2 * u], kp[2 * u + 1]};
        }
        {
            unsigned vp[16];
#pragma unroll
            for (int t = 0; t < 32; t += 2) vp[t >> 1] = (unsigned)rzv[t] | ((unsigned)rzv[t + 1] << 16);
#pragma unroll
            for (int u = 0; u < 8; ++u) *(LAS u32x2*)(VT + hg_tt(lane, u)) = (u32x2){vp[2 * u], vp[2 * u + 1]};
        }
        asm volatile("s_waitcnt lgkmcnt(0)" ::: "memory");
        f32x4 o[4][2];
        {
            bf16x8 qf[2][2], kf[2][2];
#pragma unroll
            for (int tt = 0; tt < 2; ++tt)
#pragma unroll
                for (int ks = 0; ks < 2; ++ks) {
                    qf[tt][ks] = *(const LAS bf16x8*)(QT + (16 * tt + qr) * 144 + ks * 64 + kq * 16);
                    kf[tt][ks] = *(const LAS bf16x8*)(KT + (16 * tt + qr) * 144 + ks * 64 + kq * 16);
                }
            const f32x4 zero = {0.f, 0.f, 0.f, 0.f};
            f32x4 p00 = __builtin_amdgcn_mfma_f32_16x16x32_bf16(kf[0][0], qf[0][0], zero, 0, 0, 0);
            p00 = __builtin_amdgcn_mfma_f32_16x16x32_bf16(kf[0][1], qf[0][1], p00, 0, 0, 0);
            f32x4 p01 = __builtin_amdgcn_mfma_f32_16x16x32_bf16(kf[0][0], qf[1][0], zero, 0, 0, 0);
            p01 = __builtin_amdgcn_mfma_f32_16x16x32_bf16(kf[0][1], qf[1][1], p01, 0, 0, 0);
            f32x4 p11 = __builtin_amdgcn_mfma_f32_16x16x32_bf16(kf[1][0], qf[1][0], zero, 0, 0, 0);
            p11 = __builtin_amdgcn_mfma_f32_16x16x32_bf16(kf[1][1], qf[1][1], p11, 0, 0, 0);
#pragma unroll
            for (int j = 0; j < 4; ++j) { const bool keep = (4 * kq + j) <= qr; p00[j] = keep ? p00[j] : 0.f; p11[j] = keep ? p11[j] : 0.f; }
            u32x4 w0, w1;
            w0.x = cvt_pk_b(p00[0], p00[1]); w0.y = cvt_pk_b(p00[2], p00[3]); w0.z = 0u; w0.w = 0u;
            w1.x = cvt_pk_b(p01[0], p01[1]); w1.y = cvt_pk_b(p01[2], p01[3]); w1.z = cvt_pk_b(p11[0], p11[1]); w1.w = cvt_pk_b(p11[2], p11[3]);
            const bf16x8 pb0 = __builtin_bit_cast(bf16x8, w0), pb1 = __builtin_bit_cast(bf16x8, w1);
            bf16x8 va[4], ka[4];
#pragma unroll
            for (int i = 0; i < 4; ++i) {
                const int row = 16 * i + qr;
                const u32x2 vlo = *(const LAS u32x2*)(VT + hg_tt(row, kq)), vhi = *(const LAS u32x2*)(VT + hg_tt(row, 4 + kq));
                const u32x2 klo = *(const LAS u32x2*)(KTT + hg_tt(row, kq)), khi = *(const LAS u32x2*)(KTT + hg_tt(row, 4 + kq));
                va[i] = __builtin_bit_cast(bf16x8, (u32x4){vlo.x, vlo.y, vhi.x, vhi.y});
                ka[i] = __builtin_bit_cast(bf16x8, (u32x4){klo.x, klo.y, khi.x, khi.y});
            }
            asm volatile("s_waitcnt lgkmcnt(0)" ::: "memory");
#pragma unroll
            for (int et = 0; et < 4; ++et) {
                o[et][0] = __builtin_amdgcn_mfma_f32_16x16x32_bf16(va[et], pb0, zero, 0, 0, 0);
                o[et][1] = __builtin_amdgcn_mfma_f32_16x16x32_bf16(va[et], pb1, zero, 0, 0, 0);
            }
#pragma unroll
            for (int dt = 0; dt < 4; ++dt) {
                const f32x4 Fv = *(const LAS f32x4*)(vec + 128 + 16 * dt + 4 * kq);
#pragma unroll
                for (int et = 0; et < 4; ++et) {
                    f32x4 rt = __builtin_amdgcn_mfma_f32_16x16x32_bf16(ka[dt], va[et], zero, 0, 0, 0);
                    rt = rt * Fv;
                    u32x2 w; w.x = cvt_pk(rt[0], rt[1]); w.y = cvt_pk(rt[2], rt[3]);
                    *(LAS u32x2*)(GS + hg_gs(16 * et + qr, 2 * dt + (kq >> 1)) + (kq & 1) * 8) = w;
                }
            }
        }
        __syncthreads();
#pragma unroll 1
        for (int w = 0; w < 8; ++w) {
            LAS unsigned char* gsw = lds + w * 17408 + 9216 + hg_gs(e2, u2);
            const LAS float* vw = (const LAS float*)(lds + 8 * 17408) + w * 192 + 8 * u2;
            const u32x4 g = *(const LAS u32x4*)gsw;
            const f32x4 d0 = *(const LAS f32x4*)vw, d1 = *(const LAS f32x4*)(vw + 4), E0 = *(const LAS f32x4*)(vw + 64), E1 = *(const LAS f32x4*)(vw + 68);
            u32x4 sp;
            sp.x = cvt_pk(S[0] * E0[0], S[1] * E0[1]); sp.y = cvt_pk(S[2] * E0[2], S[3] * E0[3]); sp.z = cvt_pk(S[4] * E1[0], S[5] * E1[1]); sp.w = cvt_pk(S[6] * E1[2], S[7] * E1[3]);
            *(LAS u32x4*)gsw = sp;
            S[0] = d0[0] * S[0] + bf_lo(g.x); S[1] = d0[1] * S[1] + bf_hi(g.x); S[2] = d0[2] * S[2] + bf_lo(g.y); S[3] = d0[3] * S[3] + bf_hi(g.y);
            S[4] = d1[0] * S[4] + bf_lo(g.z); S[5] = d1[1] * S[5] + bf_hi(g.z); S[6] = d1[2] * S[6] + bf_lo(g.w); S[7] = d1[3] * S[7] + bf_hi(g.w);
        }
        __syncthreads();
        {
            bf16x8 qf[2][2];
#pragma unroll
            for (int tt = 0; tt < 2; ++tt)
#pragma unroll
                for (int ks = 0; ks < 2; ++ks) qf[tt][ks] = *(const LAS bf16x8*)(QT + (16 * tt + qr) * 144 + ks * 64 + kq * 16);
#pragma unroll
            for (int et = 0; et < 4; ++et)
#pragma unroll
                for (int ks = 0; ks < 2; ++ks) {
                    const bf16x8 sa = *(const LAS bf16x8*)(GS + hg_gs(16 * et + qr, 4 * ks + kq));
                    o[et][0] = __builtin_amdgcn_mfma_f32_16x16x32_bf16(sa, qf[0][ks], o[et][0], 0, 0, 0);
                    o[et][1] = __builtin_amdgcn_mfma_f32_16x16x32_bf16(sa, qf[1][ks], o[et][1], 0, 0, 0);
                }
#pragma unroll
            for (int tt = 0; tt < 2; ++tt) {
                const int n = 16 * tt + qr;
                float* orow = OH + (size_t)(rowbase + trow0 + tstep * n) * 256 + h * 64 + 4 * kq;
#pragma unroll
                for (int et = 0; et < 4; ++et) *(f32x4*)(orow + 16 * et) = o[et][tt];
            }
        }
        asm volatile("s_waitcnt lgkmcnt(0)" ::: "memory");
    }
    if (!lat) {
        float* sf = p.out + OUT_ST + ((((size_t)bidx * 2 + l) * 2 + dir) * 4 + h) * 4096;
#pragma unroll
        for (int j = 0; j < 8; ++j) sf[(8 * u2 + j) * 64 + e2] = S[j];
    }
}

__device__ __forceinline__ void hfin_item(const Params& p, int l, int it) {
    const int tid_ = otid(); const int lane = tid_ & 63, wave = tid_ >> 6;
    const bf16_t* Z = (const bf16_t*)(p.ws + WS_HZ); const float* OH = (const float*)(p.ws + WS_OH); bf16_t* O = (bf16_t*)(p.ws + WS_A);
    const f32x4 g = *(const f32x4*)(p.in[18] + l * 256 + lane * 4);
    for (int r8 = 0; r8 < 8; ++r8) {
        const int row = it * 64 + wave * 8 + r8;
        const f32x4 a = *(const f32x4*)(OH + (size_t)row * 256 + lane * 4) + *(const f32x4*)(OH + (size_t)T * 256 + (size_t)row * 256 + lane * 4);
        float ss = (a[0] * a[0] + a[1] * a[1]) + (a[2] * a[2] + a[3] * a[3]);
        ss += __shfl_xor(ss, 1); ss += __shfl_xor(ss, 2); ss += __shfl_xor(ss, 4); ss += __shfl_xor(ss, 8);
        const float rr = 1.0f / sqrtf(ss * (1.0f / 64.0f) + 1e-6f);
        const u32x2 z = *(const u32x2*)(Z + (size_t)row * NIN + 1024 + lane * 4);
        const float o0 = a[0] * rr * g[0] * silu_f(bf_lo(z.x)), o1 = a[1] * rr * g[1] * silu_f(bf_hi(z.x));
        const float o2 = a[2] * rr * g[2] * silu_f(bf_lo(z.y)), o3 = a[3] * rr * g[3] * silu_f(bf_hi(z.y));
        u32x2 w; w.x = cvt_pk(o0, o1); w.y = cvt_pk(o2, o3);
        *(u32x2*)(O + (size_t)row * D + lane * 4) = w;
    }
}

__device__ __forceinline__ void conv_item(const Params& p, int l, int it, LAS unsigned char* lds) {
    const int tid = otid(), lane = tid & 63, wave = tid >> 6;
    LAS float* ul = (LAS float*)lds;
    LAS float* res = ul + 62 * 256;
    const bf16_t* Z = (const bf16_t*)(p.ws + WS_HZ); bf16_t* O = (bf16_t*)(p.ws + WS_A);
    const int row0 = it * 32;
    int seq0, L;
    if (row0 < TCTX) { seq0 = row0 & ~255; L = 256; } else { seq0 = TCTX + ((row0 - TCTX) & ~2047); L = 2048; }
    for (int i = tid; i < 62 * 32; i += NTHREADS) {
        const int rr = i >> 5, ch = (i & 31) * 8;
        const int prow = row0 - 15 + rr;
        f32x4 u0 = {0.f, 0.f, 0.f, 0.f}, u1 = u0;
        if (prow >= seq0 && prow < seq0 + L) {
            const u32x4 a = *(const u32x4*)(Z + (size_t)prow * NIN + 1280 + ch), b = *(const u32x4*)(Z + (size_t)prow * NIN + 1536 + ch);
            u0[0] = bf_lo(a.x) * sigmoid_f(bf_lo(b.x)); u0[1] = bf_hi(a.x) * sigmoid_f(bf_hi(b.x));
            u0[2] = bf_lo(a.y) * sigmoid_f(bf_lo(b.y)); u0[3] = bf_hi(a.y) * sigmoid_f(bf_hi(b.y));
            u1[0] = bf_lo(a.z) * sigmoid_f(bf_lo(b.z)); u1[1] = bf_hi(a.z) * sigmoid_f(bf_hi(b.z));
            u1[2] = bf_lo(a.w) * sigmoid_f(bf_lo(b.w)); u1[3] = bf_hi(a.w) * sigmoid_f(bf_hi(b.w));
        }
        *(LAS f32x4*)(ul + rr * 256 + ch) = u0; *(LAS f32x4*)(ul + rr * 256 + ch + 4) = u1;
    }
    __syncthreads();
    {
        const int c = tid & 255, half = tid >> 8;
        float w[31];
#pragma unroll
        for (int j = 0; j < 31; ++j) w[j] = p.in[19][((size_t)l * 31 + j) * 256 + c];
        const float bias = p.in[20][l * 256 + c];
        float uu[46];
#pragma unroll
        for (int i = 0; i < 46; ++i) uu[i] = ul[(half * 16 + i) * 256 + c];
#pragma unroll
        for (int pp = 0; pp < 16; ++pp) {
            float acc = bias;
#pragma unroll
            for (int j = 0; j < 31; ++j) acc += w[j] * uu[pp + j];
            res[(half * 16 + pp) * 256 + c] = acc;
        }
    }
    __syncthreads();
    {
        const f32x4 g = *(const f32x4*)(p.in[21] + l * 256 + lane * 4), b = *(const f32x4*)(p.in[22] + l * 256 + lane * 4);
#pragma unroll
        for (int r = 0; r < 4; ++r) {
            const int pp = wave * 4 + r;
            f32x4 x = *(const LAS f32x4*)(res + pp * 256 + lane * 4);
            const float mean = wave_sum((x[0] + x[1]) + (x[2] + x[3])) * (1.0f / 256.0f);
            x = x - mean;
            const float var = wave_sum((x[0] * x[0] + x[1] * x[1]) + (x[2] * x[2] + x[3] * x[3])) * (1.0f / 256.0f);
            const float rstd = 1.0f / sqrtf(var + 1e-5f);
            x = x * rstd * g + b;
            u32x2 w; w.x = cvt_pk(silu_f(x[0]), silu_f(x[1])); w.y = cvt_pk(silu_f(x[2]), silu_f(x[3]));
            *(u32x2*)(O + (size_t)(row0 + pp) * D + 256 + lane * 4) = w;
        }
    }
}

template <int NQ>
__device__ __forceinline__ void attn_item(const bf16_t* Qb, const bf16_t* Kp, const bf16_t* Vp, int Lk, int qrow0, int kvh, bf16_t* O, LAS unsigned char* lds) {
    const int tid = otid(), lane = tid & 63, wave = tid >> 6;
    const int g = wave >> 1, sub = wave & 1, head = kvh * 4 + g;
    const int qr = lane & 15, kq = lane >> 4;
    bf16x8 qf[NQ][2];
#pragma unroll
    for (int qi = 0; qi < NQ; ++qi) {
        const int row = qrow0 + sub * (16 * NQ) + qi * 16 + qr;
#pragma unroll
        for (int ks = 0; ks < 2; ++ks) qf[qi][ks] = *(const bf16x8*)(Qb + (size_t)row * 512 + head * 64 + ks * 32 + kq * 8);
    }
    f32x4 o[NQ][4]; float mrun[NQ], lsum[NQ];
#pragma unroll
    for (int qi = 0; qi < NQ; ++qi) { mrun[qi] = -1e30f; lsum[qi] = 0.f;
#pragma unroll
        for (int dt = 0; dt < 4; ++dt) o[qi][dt] = (f32x4){0.f, 0.f, 0.f, 0.f}; }
    const int skey = tid >> 3, sch = tid & 7;
    const int ntile = Lk >> 6;
    u32x4 rk = *(const u32x4*)(Kp + (size_t)skey * 64 + sch * 8), rv = *(const u32x4*)(Vp + (size_t)skey * 64 + sch * 8);
#define AT_KBUF(b) (lds + (b) * 9216)
#define AT_VBUF(b) (lds + 18432 + (b) * 8704)
#define AT_STAGE(b) do { *(LAS u32x4*)(AT_KBUF(b) + skey * 144 + sch * 16) = rk; LAS unsigned short* vt_ = (LAS unsigned short*)(AT_VBUF(b) + (sch * 8) * 136 + skey * 2); \
        vt_[0 * 68] = (unsigned short)(rv.x & 0xffffu); vt_[1 * 68] = (unsigned short)(rv.x >> 16); vt_[2 * 68] = (unsigned short)(rv.y & 0xffffu); vt_[3 * 68] = (unsigned short)(rv.y >> 16); \
        vt_[4 * 68] = (unsigned short)(rv.z & 0xffffu); vt_[5 * 68] = (unsigned short)(rv.z >> 16); vt_[6 * 68] = (unsigned short)(rv.w & 0xffffu); vt_[7 * 68] = (unsigned short)(rv.w >> 16); } while (0)
    AT_STAGE(0);
    __syncthreads();
    for (int kt = 0; kt < ntile; ++kt) {
        const int cur = kt & 1;
        if (kt + 1 < ntile) { rk = *(const u32x4*)(Kp + (size_t)((kt + 1) * 64 + skey) * 64 + sch * 8); rv = *(const u32x4*)(Vp + (size_t)((kt + 1) * 64 + skey) * 64 + sch * 8); }
        f32x4 s[NQ][4];
        const LAS unsigned char* kb = AT_KBUF(cur);
#pragma unroll
        for (int t4 = 0; t4 < 4; ++t4) {
            const bf16x8 ka0 = *(const LAS bf16x8*)(kb + (t4 * 16 + qr) * 144 + kq * 16);
            const bf16x8 ka1 = *(const LAS bf16x8*)(kb + (t4 * 16 + qr) * 144 + 64 + kq * 16);
#pragma unroll
            for (int qi = 0; qi < NQ; ++qi) {
                f32x4 z = {0.f, 0.f, 0.f, 0.f};
                z = __builtin_amdgcn_mfma_f32_16x16x32_bf16(ka0, qf[qi][0], z, 0, 0, 0);
                s[qi][t4] = __builtin_amdgcn_mfma_f32_16x16x32_bf16(ka1, qf[qi][1], z, 0, 0, 0);
            }
        }
        bf16x8 pb[NQ][2];
#pragma unroll
        for (int qi = 0; qi < NQ; ++qi) {
            float mx = -1e30f;
#pragma unroll
            for (int t4 = 0; t4 < 4; ++t4) mx = fmaxf(mx, fmaxf(fmaxf(s[qi][t4][0], s[qi][t4][1]), fmaxf(s[qi][t4][2], s[qi][t4][3])));
            mx = fmaxf(mx, __shfl_xor(mx, 16)); mx = fmaxf(mx, __shfl_xor(mx, 32));
            const float mnew = fmaxf(mrun[qi], mx);
            const float alpha = __builtin_amdgcn_exp2f(mrun[qi] - mnew);
            mrun[qi] = mnew;
            float psum = 0.f;
#pragma unroll
            for (int t4 = 0; t4 < 4; ++t4)
#pragma unroll
                for (int j = 0; j < 4; ++j) { const float pv = __builtin_amdgcn_exp2f(s[qi][t4][j] - mnew); s[qi][t4][j] = pv; psum += pv; }
            lsum[qi] = lsum[qi] * alpha + psum;
#pragma unroll
            for (int dt = 0; dt < 4; ++dt) o[qi][dt] = o[qi][dt] * alpha;
#pragma unroll
            for (int kp = 0; kp < 2; ++kp) {
                u32x4 w; w.x = cvt_pk_c(s[qi][2 * kp][0], s[qi][2 * kp][1]); w.y = cvt_pk_c(s[qi][2 * kp][2], s[qi][2 * kp][3]);
                w.z = cvt_pk_c(s[qi][2 * kp + 1][0], s[qi][2 * kp + 1][1]); w.w = cvt_pk_c(s[qi][2 * kp + 1][2], s[qi][2 * kp + 1][3]);
                pb[qi][kp] = __builtin_bit_cast(bf16x8, w);
            }
        }
        const LAS unsigned char* vb = AT_VBUF(cur);
#pragma unroll
        for (int dt = 0; dt < 4; ++dt)
#pragma unroll
            for (int kp = 0; kp < 2; ++kp) {
                const u32x2 lo = *(const LAS u32x2*)(vb + (dt * 16 + qr) * 136 + ((2 * kp) * 16 + kq * 4) * 2);
                const u32x2 hi = *(const LAS u32x2*)(vb + (dt * 16 + qr) * 136 + ((2 * kp + 1) * 16 + kq * 4) * 2);
                const u32x4 w = {lo.x, lo.y, hi.x, hi.y};
                const bf16x8 va = __builtin_bit_cast(bf16x8, w);
#pragma unroll
                for (int qi = 0; qi < NQ; ++qi) o[qi][dt] = __builtin_amdgcn_mfma_f32_16x16x32_bf16(va, pb[qi][kp], o[qi][dt], 0, 0, 0);
            }
        if (kt + 1 < ntile) AT_STAGE(cur ^ 1);
        __syncthreads();
    }
#undef AT_STAGE
#undef AT_KBUF
#undef AT_VBUF
#pragma unroll
    for (int qi = 0; qi < NQ; ++qi) {
        float ls = lsum[qi]; ls += __shfl_xor(ls, 16); ls += __shfl_xor(ls, 32);
        const float inv = 1.0f / ls;
        const int row = qrow0 + sub * (16 * NQ) + qi * 16 + qr;
#pragma unroll
        for (int dt = 0; dt < 4; ++dt) {
            const f32x4 v = o[qi][dt] * inv;
            u32x2 w; w.x = cvt_pk_c(v[0], v[1]); w.y = cvt_pk_c(v[2], v[3]);
            *(u32x2*)(O + (size_t)row * D + 512 + head * 64 + dt * 16 + kq * 4) = w;
        }
    }
}

__device__ __forceinline__ void mix_a(const Params& p, int l, unsigned* ctr, LAS unsigned char* lds) {
    LAS int* slot = (LAS int*)(lds + LDS_BYTES - 64);
    constexpr int N_HL = 16, N_HC = 256, N_CV = 384, N_PR = 192, N_PC = 8, TOT = N_HL + N_HC + N_CV + N_PR + N_PC;
    int qk = 0;
    for (;;) {
        int it = next_item(ctr, slot, qk, N_HL);
        if (it >= TOT) break;
        if (it < N_HL) { const int dir = it & 1, h = (it >> 1) & 3, b = it >> 3; hgrn_chain(p, l, 2048, TCTX + b * 2048, b, true, h, dir, lds); if (REP_MASK & 64) { __syncthreads(); hgrn_chain(p, l, 2048, TCTX + b * 2048, b, true, h, dir, lds); } continue; }
        it -= N_HL;
        if (it < N_HC) { const int dir = it & 1, h = (it >> 1) & 3, s = it >> 3; hgrn_chain(p, l, 256, s * 256, s, false, h, dir, lds); continue; }
        it -= N_HC;
        if (it < N_CV) { conv_item(p, l, it, lds); if (REP_MASK & 128) { __syncthreads(); conv_item(p, l, it, lds); } continue; }
        it -= N_CV;
        if (it < N_PR) { prep_item(p, l, it); if (REP_MASK & 256) prep_item(p, l, it); continue; }
        it -= N_PR;
        prepc_item(p, l, it);
    }
}
__device__ __forceinline__ void mix_b(const Params& p, int l, unsigned* ctr, LAS unsigned char* lds) {
    LAS int* slot = (LAS int*)(lds + LDS_BYTES - 64);
    constexpr int N_AL = 256, N_AC = 256, N_HF = 192, TOT = N_AL + N_AC + N_HF;
    const bf16_t* Qb = (const bf16_t*)(p.ws + WS_Q); const bf16_t* Kb = (const bf16_t*)(p.ws + WS_K); const bf16_t* Vb = (const bf16_t*)(p.ws + WS_V);
    bf16_t* O = (bf16_t*)(p.ws + WS_A);
    int qk = 0;
    for (;;) {
        int it = next_item(ctr, slot, qk);
        if (it >= TOT) break;
        if (it < N_AL) {
            const int qt = it & 63, kvh = (it >> 6) & 1, b = it >> 7;
            const size_t off = (size_t)KV_LAT_OFF + (size_t)(b * 2 + kvh) * 2560 * 64;
            if (EN_MASK & 64) attn_item<1>(Qb, Kb + off, Vb + off, 2560, TCTX + b * 2048 + qt * 32, kvh, O, lds);
            continue;
        }
        it -= N_AL;
        if (it < N_AC) {
            const int qt = it & 3, kvh = (it >> 2) & 1, s = it >> 3;
            const size_t off = (size_t)(s * 2 + kvh) * 256 * 64;
            if (EN_MASK & 128) attn_item<2>(Qb, Kb + off, Vb + off, 256, s * 256 + qt * 64, kvh, O, lds);
            continue;
        }
        it -= N_AC;
        if (EN_MASK & 256) hfin_item(p, l, it);
    }
}

#define XB_TMO      128
#define XB_XCNT(j)  (256  + 64 * (j))
#define XB_XSUB(j)  (1280 + 64 * (j))
#define XB_XGEN(j)  (2304 + 64 * (j))
#define XB_TOP      3328
#define XB_TOPGEN   3392
#define XCD_BAR_WORDS 3456
#define XB_SPIN_CAP (1u << 18)

__device__ __forceinline__ unsigned xb_ld(unsigned* p)              { return __hip_atomic_load(p, __ATOMIC_RELAXED, __HIP_MEMORY_SCOPE_AGENT); }
__device__ __forceinline__ unsigned xb_add(unsigned* p, unsigned v) { return __hip_atomic_fetch_add(p, v, __ATOMIC_RELAXED, __HIP_MEMORY_SCOPE_AGENT); }
__device__ __forceinline__ unsigned xb_xcc_id() { return (unsigned)__builtin_amdgcn_s_getreg((3 << 11) | 20) & 0xFu; }
#define XB_SPIN(cond, bar) do { unsigned _sp = 0; while (cond) { __builtin_amdgcn_s_sleep(1); \
    if ((++_sp & 255u) == 0u) { if (xb_ld(&(bar)[XB_TMO])) break; if (_sp > XB_SPIN_CAP) { atomicAdd(&(bar)[XB_TMO], 1u); break; } } } } while (0)

struct XcdBarrier {
    unsigned* bar; unsigned x;
    volatile LAS unsigned* st;
};

__device__ __forceinline__ XcdBarrier xcd_barrier_post(unsigned* bar, volatile LAS unsigned* st) {
    XcdBarrier b; b.bar = bar; b.x = xb_xcc_id(); b.st = st;
    if (threadIdx.x == 0) (void)xb_add(&bar[XB_XCNT(b.x)], 1u);
    return b;
}
__device__ __forceinline__ void xcd_barrier_complete(unsigned* bar, unsigned x, unsigned& nloc, unsigned& nx) {
    const unsigned G = gridDim.x * gridDim.y * gridDim.z;
    unsigned sum, cnt, mine, sp = 0u;
    for (;;) {
        sum = 0u; cnt = 0u; mine = 0u;
#pragma unroll
        for (unsigned j = 0; j < 16; ++j) { const unsigned c = xb_ld(&bar[XB_XCNT(j)]); sum += c; cnt += (c > 0u) ? 1u : 0u; mine = (j == x) ? c : mine; }
        if (sum == G) break;
        __builtin_amdgcn_s_sleep(1);
        if ((++sp & 255u) == 0u) { if (xb_ld(&bar[XB_TMO])) break; if (sp > XB_SPIN_CAP) { atomicAdd(&bar[XB_TMO], 1u); break; } }
    }
    nloc = mine > 0u ? mine : 1u; nx = cnt > 0u ? cnt : 1u;
}

__device__ __forceinline__ void xcd_barrier(const XcdBarrier& b) {
    asm volatile("s_waitcnt vmcnt(0)" ::: "memory");
    __syncthreads();
    if (threadIdx.x == 0) {
        unsigned* bar = b.bar;
        __builtin_amdgcn_s_waitcnt(0);
        unsigned nloc = b.st[0], nx = b.st[1];
        if (nloc == 0u) { xcd_barrier_complete(bar, b.x, nloc, nx); b.st[0] = nloc; b.st[1] = nx; }
        const unsigned old = xb_add(&bar[XB_XSUB(b.x)], 1u);
        const unsigned gen = old / nloc;
        if (old + 1u == (gen + 1u) * nloc) {
            __builtin_amdgcn_fence(__ATOMIC_RELEASE, "agent");
            asm volatile("s_waitcnt vmcnt(0)" ::: "memory");
            const unsigned og = xb_add(&bar[XB_TOP], 1u);
            const unsigned tg = og / nx;
            if (og + 1u == (tg + 1u) * nx) xb_add(&bar[XB_TOPGEN], 1u);
            else XB_SPIN(xb_ld(&bar[XB_TOPGEN]) == tg, bar);
            __builtin_amdgcn_fence(__ATOMIC_ACQUIRE, "agent");
            xb_add(&bar[XB_XGEN(b.x)], 1u);
            asm volatile("s_waitcnt vmcnt(0)" ::: "memory");
        } else {
            XB_SPIN(xb_ld(&bar[XB_XGEN(b.x)]) == gen, bar);
            __builtin_amdgcn_fence(__ATOMIC_ACQUIRE, "agent");
            asm volatile("s_waitcnt vmcnt(0)" ::: "memory");
        }
    }
    __syncthreads();
}

__global__ void __launch_bounds__(NTHREADS, 2) fwd_megakernel(Params p) {
    extern __shared__ __attribute__((aligned(16))) unsigned char lds_raw[];
    LAS unsigned char* lds = (LAS unsigned char*)lds_raw;
    cg::grid_group grid = cg::this_grid();
#define GSYNC1() xcd_barrier(xbar)
#define GSYNC() do { GSYNC1(); if (REP_MASK & 32) GSYNC1(); } while (0)
    const int G = gridDim.x, c = blockIdx.x;
    unsigned* ctl = (unsigned*)(p.ws + WS_CTL);
    { volatile LAS unsigned* st0 = (volatile LAS unsigned*)(lds + LDS_BYTES - 32); if (threadIdx.x < 2) st0[threadIdx.x] = 0u; }
    __syncthreads();
    grid.sync();
    const XcdBarrier xbar = xcd_barrier_post(ctl + 1024, (volatile LAS unsigned*)(lds + LDS_BYTES - 32));
    float* X = (float*)(p.ws + WS_X);
    const bf16_t* A = (const bf16_t*)(p.ws + WS_A);
    bf16_t* HZ = (bf16_t*)(p.ws + WS_HZ);
    const float* MOD = (const float*)(p.ws + WS_MOD);

    if (EN_MASK & 32) prologue(p, lds);
    if (REP_MASK & 1) { __syncthreads(); prologue(p, lds); }
    GSYNC();
    init_rows(p);
    GSYNC();
#pragma unroll 1
    for (int l = 0; l < 2; ++l) {
        const unsigned char* wl = p.ws + WS_W + (size_t)l * W_LAYER;
        const float* modl = MOD + (size_t)l * 3 * NMOD;
        { pg8::Gemm g{A, (const bf16_t*)(wl + W_1IN), T, 2 * DFF, D}; pg8::StaticOrder S; S.init(T, 2 * DFF, G, c); EpiSwiglu E{HZ};
          if (EN_MASK & 1) pg8::gemm_phase<EpiSwiglu, pg8::StaticOrder, true, true>(lds, g, S, E);
          if (REP_MASK & 2) pg8::gemm_phase<EpiSwiglu, pg8::StaticOrder, true, true>(lds, g, S, E); }
        GSYNC();
        { pg8::Gemm g{HZ, (const bf16_t*)(wl + W_1OUT), T, D, DFF}; pg8::StaticOrder S; S.init(T, D, G, c); EpiResid E{X, modl + 2 * 1024, 0.5f};
          if (EN_MASK & 2) pg8::gemm_phase<EpiResid, pg8::StaticOrder, true, true>(lds, g, S, E); }
        GSYNC();
        ln_rows(p, p.in[9] + (size_t)(l * 3 + 0) * D, p.in[10] + (size_t)(l * 3 + 0) * D, modl, 3, nullptr);
        GSYNC();
        { pg8::Gemm g{A, (const bf16_t*)(wl + W_IN), T, NIN, D}; pg8::StaticOrder S; S.init(T, NIN, G, c); EpiZ E{HZ, NIN};
          if (EN_MASK & 4) pg8::gemm_phase<EpiZ, pg8::StaticOrder, true, true>(lds, g, S, E);
          if (REP_MASK & 4) pg8::gemm_phase<EpiZ, pg8::StaticOrder, true, true>(lds, g, S, E); }
        GSYNC();
        if (EN_MASK & 8) mix_a(p, l, ctl + 64 * (2 * l), lds);
        if (REP_MASK & 8) mix_a(p, l, ctl + 64 * (2 * l), lds);
        GSYNC();
        if (EN_MASK & 16) mix_b(p, l, ctl + 64 * (2 * l + 1), lds);
        if (REP_MASK & 16) mix_b(p, l, ctl + 64 * (2 * l + 1), lds);
        GSYNC();
        { pg8::Gemm g{A, (const bf16_t*)(wl + W_OUT), T, D, D}; pg8::StaticOrder S; S.init(T, D, G, c); EpiResid E{X, modl + 5 * 1024, 1.0f};
          if (EN_MASK & 2) pg8::gemm_phase<EpiResid, pg8::StaticOrder, true, true>(lds, g, S, E); }
        GSYNC();
        ln_rows(p, p.in[9] + (size_t)(l * 3 + 1) * D, p.in[10] + (size_t)(l * 3 + 1) * D, modl, 6, nullptr);
        GSYNC();
        { pg8::Gemm g{A, (const bf16_t*)(wl + W_2IN), T, 2 * DFF, D}; pg8::StaticOrder S; S.init(T, 2 * DFF, G, c); EpiSwiglu E{HZ};
          if (EN_MASK & 1) pg8::gemm_phase<EpiSwiglu, pg8::StaticOrder, true, true>(lds, g, S, E);
          if (REP_MASK & 2) pg8::gemm_phase<EpiSwiglu, pg8::StaticOrder, true, true>(lds, g, S, E); }
        GSYNC();
        { pg8::Gemm g{HZ, (const bf16_t*)(wl + W_2OUT), T, D, DFF}; pg8::StaticOrder S; S.init(T, D, G, c); EpiResid E{X, modl + 8 * 1024, 0.5f};
          if (EN_MASK & 2) pg8::gemm_phase<EpiResid, pg8::StaticOrder, true, true>(lds, g, S, E); }
        GSYNC();
        if (l == 0) {
            ln_rows(p, p.in[9] + (size_t)(l * 3 + 2) * D, p.in[10] + (size_t)(l * 3 + 2) * D, MOD + (size_t)3 * NMOD, 0, nullptr);
            GSYNC();
        } else {
            ln_rows(p, p.in[9] + (size_t)(l * 3 + 2) * D, p.in[10] + (size_t)(l * 3 + 2) * D, MOD, 0, p.out + OUT_Y);
        }
    }
}

extern "C" void kernel_launch(void* const* d_in, const int* in_sizes, int n_in, void* d_out, int out_size, void* d_ws, size_t ws_size, hipStream_t stream) {
    static int grid_blocks = 0;
    if (grid_blocks == 0) {
        if (n_in != 25 || ws_size < WS_END) { fprintf(stderr, "kernel_launch: unexpected n_in %d or ws_size %zu (< %zu)\n", n_in, ws_size, (size_t)WS_END); grid_blocks = -1; return; }
        int dev = 0, cus = 0, per_cu = 0;
        hipGetDevice(&dev);
        hipDeviceGetAttribute(&cus, hipDeviceAttributeMultiprocessorCount, dev);
        if (hipFuncSetAttribute((const void*)fwd_megakernel, hipFuncAttributeMaxDynamicSharedMemorySize, LDS_BYTES) != hipSuccess) { fprintf(stderr, "kernel_launch: hipFuncSetAttribute failed\n"); grid_blocks = -1; return; }
        if (hipOccupancyMaxActiveBlocksPerMultiprocessor(&per_cu, (const void*)fwd_megakernel, NTHREADS, LDS_BYTES) != hipSuccess || per_cu < 1) { fprintf(stderr, "kernel_launch: occupancy query failed (%d)\n", per_cu); per_cu = 1; }
        (void)hipGetLastError();
        grid_blocks = cus * per_cu;
    }
    if (grid_blocks < 0) return;
    hipMemsetAsync((char*)d_ws + WS_CTL, 0, CTL_BYTES, stream);
    Params p{};
    for (int i = 0; i < 25; ++i) p.in[i] = (const float*)d_in[i];
    p.out = (float*)d_out; p.ws = (unsigned char*)d_ws;
    void* args[] = {&p};
    hipError_t e = hipLaunchCooperativeKernel((const void*)fwd_megakernel, dim3(grid_blocks), dim3(NTHREADS), args, LDS_BYTES, stream);
    if (e != hipSuccess) fprintf(stderr, "cooperative launch failed: %s (grid %d)\n", hipGetErrorString(e), grid_blocks);
}
```
